# Optimizing an MI355X kernel written in HIP

```python
import math
import jax, jax.numpy as jnp
from jax import lax
import numpy as np

D_MODEL = 1024
BATCH = 1
SEQ = 16384
DEPTH = 1

HEAD_DIM = 64
SWA_HEADS = 8
SWA_KV_HEADS = 2
SWA_GROUP = SWA_HEADS // SWA_KV_HEADS
WINDOW = 128
FOX_HEADS = 8
BLOCK = 128
REL_BUCKETS = 32
REL_MAX_DIST = WINDOW
N_EXPERTS = 32
TOP_K = 4
D_FF = D_MODEL
SWIGLU_LIMIT = 7.0
SWIGLU_ALPHA = 1.702
RMS_EPS = 1e-5
N_MOD = 6

SWA_Q = SWA_HEADS * HEAD_DIM
SWA_KV = SWA_KV_HEADS * HEAD_DIM
FOX_W = FOX_HEADS * HEAD_DIM
IN_SPLITS = (SWA_Q, SWA_KV, SWA_KV, FOX_W, FOX_W, FOX_W, FOX_HEADS, D_MODEL, D_MODEL)
D_IN = sum(IN_SPLITS)

kernel_name = "gated_hybrid_swa_fox_moe_adaln"


def rms_norm(x, g):
    xf = x.astype(jnp.float32)
    y = xf * lax.rsqrt(jnp.mean(xf * xf, axis=-1, keepdims=True) + RMS_EPS)
    return (y * g.astype(jnp.float32)).astype(x.dtype)


def modulate(h, shift, scale):
    return h * (1.0 + scale[:, None, :]) + shift[:, None, :]


def t5_causal_buckets(dist):
    n = jnp.maximum(dist, 0)
    max_exact = REL_BUCKETS // 2
    nf = jnp.maximum(n, 1).astype(jnp.float32)
    large = max_exact + (jnp.log(nf / max_exact) / math.log(REL_MAX_DIST / max_exact)
                         * (REL_BUCKETS - max_exact)).astype(jnp.int32)
    large = jnp.minimum(large, REL_BUCKETS - 1)
    return jnp.where(n < max_exact, n, large)


def sliding_window_gqa(q, k, v, sinks, rel_table):
    B, S = q.shape[0], q.shape[1]
    nb = S // BLOCK
    qb = q.reshape(B, nb, BLOCK, SWA_KV_HEADS, SWA_GROUP, HEAD_DIM)
    kb = k.reshape(B, nb, BLOCK, SWA_KV_HEADS, HEAD_DIM)
    vb = v.reshape(B, nb, BLOCK, SWA_KV_HEADS, HEAD_DIM)
    shift = lambda t: jnp.concatenate([jnp.zeros_like(t[:, :1]), t[:, :-1]], axis=1)
    kk = jnp.concatenate([shift(kb), kb], axis=2)
    vv = jnp.concatenate([shift(vb), vb], axis=2)
    scores = jnp.einsum('bnqhgd,bnkhd->bnhgqk', qb, kk).astype(jnp.float32) * (HEAD_DIM ** -0.5)

    qi = jnp.arange(BLOCK)[:, None]
    kj = jnp.arange(2 * BLOCK)[None, :]
    dist = BLOCK + qi - kj
    bias = rel_table.astype(jnp.float32)[t5_causal_buckets(dist)]
    bias = bias.transpose(2, 0, 1).reshape(SWA_KV_HEADS, SWA_GROUP, BLOCK, 2 * BLOCK)
    band = (dist >= 0) & (dist < WINDOW)
    blk = jnp.arange(nb)[:, None, None]
    key_ok = (blk * BLOCK - BLOCK + kj[None]) >= 0
    mask = band[None] & key_ok
    scores = jnp.where(mask[None, :, None, None], scores + bias, -jnp.inf)

    sink = jnp.broadcast_to(sinks.astype(jnp.float32).reshape(SWA_KV_HEADS, SWA_GROUP)[None, None, :, :, None, None],
                            scores.shape[:-1] + (1,))
    p = jax.nn.softmax(jnp.concatenate([scores, sink], axis=-1), axis=-1)[..., :-1]
    out = jnp.einsum('bnhgqk,bnkhd->bnqhgd', p.astype(v.dtype), vv)
    return out.reshape(B, S, SWA_Q)


def forgetting_attention(q, k, v, logf):
    B, S = q.shape[0], q.shape[1]
    nb = S // BLOCK
    cum_t = lax.cumsum(logf.astype(jnp.float32), axis=1).transpose(0, 2, 1)
    kpos = jnp.arange(S)

    def one_block(i):
        start = i * BLOCK
        qi = lax.dynamic_slice_in_dim(q, start, BLOCK, axis=1)
        ci = lax.dynamic_slice_in_dim(cum_t, start, BLOCK, axis=2)
        s = (jnp.einsum('bqhd,bkhd->bhqk', qi, k).astype(jnp.float32) * (HEAD_DIM ** -0.5)
             + ci[..., None] - cum_t[:, :, None, :])
        qpos = start + jnp.arange(BLOCK)
        s = jnp.where(qpos[:, None] >= kpos[None, :], s, -jnp.inf)
        p = jax.nn.softmax(s, axis=-1).astype(v.dtype)
        return jnp.einsum('bhqk,bkhd->bqhd', p, v)

    out = lax.map(one_block, jnp.arange(nb))
    return out.transpose(1, 0, 2, 3, 4).reshape(B, S, FOX_W)


def moe_ffn(u, w_router, b_router, w_e1, b_e1, w_e2, b_e2):
    logits = (u @ w_router).astype(jnp.float32) + b_router.astype(jnp.float32)
    top_v, top_i = lax.top_k(logits, TOP_K)
    top_w = jax.nn.softmax(top_v, axis=-1)
    combine = jnp.sum(jax.nn.one_hot(top_i, N_EXPERTS, dtype=jnp.float32) * top_w[..., None], axis=-2)
    combine = combine.astype(u.dtype)
    out = jnp.zeros_like(u)
    for e in range(N_EXPERTS):
        h = u @ w_e1[e] + b_e1[e]
        glu = jnp.minimum(h[..., ::2], SWIGLU_LIMIT)
        lin = jnp.clip(h[..., 1::2], -SWIGLU_LIMIT, SWIGLU_LIMIT)
        a = glu * jax.nn.sigmoid(SWIGLU_ALPHA * glu) * (lin + 1.0)
        out = out + combine[..., e:e + 1] * (a @ w_e2[e] + b_e2[e])
    return out


def setup_inputs(seed: int = 0) -> dict:
    key = jax.random.key(seed)
    ks = jax.random.split(key, 20)
    f32 = jnp.float32
    nrm = lambda k, shape, s: jax.random.normal(k, shape, f32) * s
    return {
        "x": nrm(ks[0], (BATCH, SEQ, D_MODEL), 1.0),
        "c": nrm(ks[1], (BATCH, D_MODEL), 1.0),
        "w_ada": nrm(ks[2], (DEPTH, D_MODEL, N_MOD * D_MODEL), D_MODEL ** -0.5),
        "b_ada": nrm(ks[3], (DEPTH, N_MOD * D_MODEL), 0.02),
        "g_mix": 1.0 + nrm(ks[4], (DEPTH, D_MODEL), 0.02),
        "w_in": nrm(ks[5], (DEPTH, D_MODEL, D_IN), D_MODEL ** -0.5),
        "b_forget": 2.0 + nrm(ks[6], (DEPTH, FOX_HEADS), 0.5),
        "sinks": nrm(ks[7], (DEPTH, SWA_HEADS), 0.5),
        "rel_bias": nrm(ks[8], (REL_BUCKETS, SWA_HEADS), 0.1),
        "w_proj_a": nrm(ks[9], (DEPTH, SWA_Q, D_MODEL), SWA_Q ** -0.5),
        "w_proj_b": nrm(ks[10], (DEPTH, FOX_W, D_MODEL), FOX_W ** -0.5),
        "w_out": nrm(ks[11], (DEPTH, D_MODEL, D_MODEL), D_MODEL ** -0.5),
        "g_ffn": 1.0 + nrm(ks[12], (DEPTH, D_MODEL), 0.02),
        "w_router": nrm(ks[13], (DEPTH, D_MODEL, N_EXPERTS), D_MODEL ** -0.5),
        "b_router": nrm(ks[14], (DEPTH, N_EXPERTS), 0.01),
        "w_e1": nrm(ks[15], (DEPTH, N_EXPERTS, D_MODEL, 2 * D_FF), D_MODEL ** -0.5),
        "b_e1": nrm(ks[16], (DEPTH, N_EXPERTS, 2 * D_FF), 0.02),
        "w_e2": nrm(ks[17], (DEPTH, N_EXPERTS, D_FF, D_MODEL), D_FF ** -0.5),
        "b_e2": nrm(ks[18], (DEPTH, N_EXPERTS, D_MODEL), 0.02),
        "g_final": 1.0 + nrm(ks[19], (D_MODEL,), 0.02),
    }


def reference(x, c, w_ada, b_ada, g_mix, w_in, b_forget, sinks, rel_bias, w_proj_a, w_proj_b, w_out,
              g_ffn, w_router, b_router, w_e1, b_e1, w_e2, b_e2, g_final):
    B, S = x.shape[0], x.shape[1]
    split_idx = [int(v) for v in np.cumsum(IN_SPLITS)[:-1]]
    c_act = jax.nn.silu(c)
    for l in range(DEPTH):
        mod = c_act @ w_ada[l] + b_ada[l]
        sh_m, sc_m, gt_m, sh_f, sc_f, gt_f = jnp.split(mod, N_MOD, axis=-1)

        u = modulate(rms_norm(x, g_mix[l]), sh_m, sc_m)
        z = u @ w_in[l]
        qa, ka, va, qb, kb, vb, fb, ga, gb = jnp.split(z, split_idx, axis=-1)
        ya = sliding_window_gqa(qa.reshape(B, S, SWA_HEADS, HEAD_DIM),
                                ka.reshape(B, S, SWA_KV_HEADS, HEAD_DIM),
                                va.reshape(B, S, SWA_KV_HEADS, HEAD_DIM),
                                sinks[l], rel_bias)
        logf = jax.nn.log_sigmoid(fb.astype(jnp.float32) + b_forget[l].astype(jnp.float32))
        yb = forgetting_attention(qb.reshape(B, S, FOX_HEADS, HEAD_DIM),
                                  kb.reshape(B, S, FOX_HEADS, HEAD_DIM),
                                  vb.reshape(B, S, FOX_HEADS, HEAD_DIM), logf)
        merged = jax.nn.sigmoid(ga) * (ya @ w_proj_a[l]) + jax.nn.sigmoid(gb) * (yb @ w_proj_b[l])
        x = x + gt_m[:, None, :] * (merged @ w_out[l])

        u = modulate(rms_norm(x, g_ffn[l]), sh_f, sc_f)
        x = x + gt_f[:, None, :] * moe_ffn(u, w_router[l], b_router[l], w_e1[l], b_e1[l], w_e2[l], b_e2[l])
    return rms_norm(x, g_final)
```

```cpp
#include <hip/hip_runtime.h>
#include <cstdint>
#include <cstdio>
#include <cmath>


namespace pg8 {
#define PG8_LAS __attribute__((address_space(3)))
typedef unsigned short bf16_t;
typedef short bf16x8 __attribute__((ext_vector_type(8)));
typedef float f32x4 __attribute__((ext_vector_type(4)));
typedef float f32x2 __attribute__((ext_vector_type(2)));
typedef unsigned u32x4 __attribute__((ext_vector_type(4)));
typedef unsigned u32x2 __attribute__((ext_vector_type(2)));
constexpr int BM = 256, BK = 64, HALF = 128, HTB = HALF * BK * 2  , STAGE_BYTES = 8 * HTB, NXCD = 8, WGM = 8;

__host__ __device__ __forceinline__ int lds_byte(int r, int c) { const int st = (r >> 4) * 2 + (c >> 5), rr = r & 15, cc = c & 31, ob = rr * 64 + cc * 2; return st * 1024 + (ob ^ (((ob >> 9) & 1) << 5)); }
__host__ __device__ __forceinline__ void stage_rc(int b, int& R, int& C) { const int st = b / 1024, sb = b % 1024, swz = sb ^ (((sb >> 9) & 1) << 5); R = (st >> 1) * 16 + swz / 64; C = (st & 1) * 32 + (swz % 64) / 2; }
__host__ __device__ __forceinline__ int perm32(int rho) { const int n = rho >> 4, i = rho & 15; return 8 * (i >> 2) + 4 * n + (i & 3); }

struct Unit { const char* A; const char* B; int pm, pn, e, slot; };
__device__ __forceinline__ const char* uniform_ptr(const char* p) { const unsigned long long v = (unsigned long long)p; const unsigned lo = __builtin_amdgcn_readfirstlane((unsigned)v), hi = __builtin_amdgcn_readfirstlane((unsigned)(v >> 32)); return (const char*)(((unsigned long long)hi << 32) | lo); }

struct DenseOrder {
    const char* A; const char* Bt; int nM, nN, nwg, G, c, K;
    __device__ void init(const void* A_, const void* Bt_, int M, int N, int K_, int G_, int c_) { A = (const char*)A_; Bt = (const char*)Bt_; nM = M / BM; nN = N / BM; nwg = nM * nN; G = G_; c = c_; K = K_; }
    __device__ bool next(int i, Unit& u) const {
        const long L = (long)i * G + c; if (L >= nwg) return false;
        int wgid = (int)L; { const int q = nwg / NXCD, r = nwg % NXCD, xcd = wgid % NXCD, off = wgid / NXCD; wgid = (xcd < r ? xcd * (q + 1) : r * (q + 1) + (xcd - r) * q) + off; }
        const int nig = WGM * nN, gid = wgid / nig, fm = gid * WGM, gsz = (nM - fm) < WGM ? (nM - fm) : WGM;
        u.pm = fm + ((wgid % nig) % gsz); u.pn = (wgid % nig) / gsz; u.e = 0; u.slot = 0;
        u.A = A + (size_t)u.pm * BM * K * 2; u.B = Bt + (size_t)u.pn * BM * K * 2; return true;
    }
    __device__ __forceinline__ int arow(int, int) const { return 0; }
};

__device__ __forceinline__ unsigned cvt_pk_bf16(float lo, float hi) { unsigned r; asm volatile("v_cvt_pk_bf16_f32 %0, %1, %2" : "=v"(r) : "v"(lo), "v"(hi)); return r; }
__device__ __forceinline__ float bf_lo(unsigned w) { return __uint_as_float(w << 16); }
__device__ __forceinline__ float bf_hi(unsigned w) { return __uint_as_float(w & 0xffff0000u); }
__device__ __forceinline__ float sigm(float x) { return __builtin_amdgcn_rcpf(1.f + __expf(-x)); }

typedef int v4i_t __attribute__((ext_vector_type(4)));
typedef int v8i_t __attribute__((ext_vector_type(8)));
__device__ __forceinline__ v8i_t cat16(bf16x8 a, bf16x8 b) { const v4i_t x = __builtin_bit_cast(v4i_t, a), y = __builtin_bit_cast(v4i_t, b); return __builtin_shufflevector(x, y, 0, 1, 2, 3, 4, 5, 6, 7); }
__device__ __forceinline__ void mfma_fp8(f32x4& acc, v8i_t a, v8i_t b, int sa, int sb) {
    asm volatile("v_mfma_scale_f32_16x16x128_f8f6f4 %0, %1, %2, %0, %3, %4 op_sel_hi:[0,0,0]" : "+v"(acc) : "v"(a), "v"(b), "v"(sa), "v"(sb)); }
template <class Epi, class Sched, bool ALIGN_EPI, bool GATHER, bool FP8 = false>
__device__ __forceinline__ void gemm_phase(PG8_LAS unsigned char* lds, const int K, const Sched& S, const Epi& E) {
    const int tid = threadIdx.x, wid = __builtin_amdgcn_readfirstlane(tid >> 6), lane = tid & 63, wr = wid >> 2, wc = wid & 3, fr = lane & 15, fq = lane >> 4;
    const int RB = FP8 ? K : K * 2;
    const int nt = RB / 128;
    unsigned voffA[2], voffB[2]; int R0, C0;
    { stage_rc(tid * 16, R0, C0); const int Rb = Epi::PERM ? ((R0 & ~31) + perm32(R0 & 31)) : R0;
      voffA[0] = (unsigned)(R0 * RB + C0 * 2); voffB[0] = (unsigned)(Rb * RB + C0 * 2); voffA[1] = voffA[0] + 64u * (unsigned)RB; voffB[1] = voffB[0] + 64u * (unsigned)RB; }
    const size_t kstep = (size_t)(BK * 2);
    const size_t hstep = (size_t)HALF * RB;
    const unsigned ldsw = (unsigned)wid * 1024u;
    const int aoff = lds_byte(wr * 64 + fr, fq * 8), boff = lds_byte(wc * 32 + fr, fq * 8);
#define PG8_SA(b, h) (((b) * 2 + (h)) * HTB)
#define PG8_SB(b, h) ((4 + (b) * 2 + (h)) * HTB)
    const unsigned ldsu = (unsigned)(uintptr_t)lds + ldsw;
#define PG8_DMA_S(sbase, voff_, ldsaddr) do { unsigned _keep; asm volatile("s_mov_b32 %0, m0\n\ts_mov_b32 m0, %3\n\ts_nop 0\n\tglobal_load_lds_dwordx4 %2, %1\n\ts_mov_b32 m0, %0" : "=&s"(_keep) : "s"((const char*)(sbase)), "v"(voff_), "s"(ldsaddr) : "memory"); } while (0)
#define PG8_STAGE(bufoff, gbase, voff) do { _Pragma("unroll") for (int _i = 0; _i < 2; ++_i) { \
        if constexpr (FP8) PG8_DMA_S((const char*)(gbase) + (size_t)_i * 64 * RB, (voff)[0], ldsu + (unsigned)((bufoff) + _i * 8192)); \
        else __builtin_amdgcn_global_load_lds((const unsigned*)((const char*)(gbase) + (voff)[_i]), (PG8_LAS unsigned*)(lds + (bufoff) + ldsw + _i * 8192), 16, 0, 0); } } while (0)
#define PG8_STAGE_G(bufoff, gbase, voff) do { _Pragma("unroll") for (int _i = 0; _i < 2; ++_i) { \
        if constexpr (FP8) PG8_DMA_S((const char*)(gbase), (voff)[_i], ldsu + (unsigned)((bufoff) + _i * 8192)); \
        else __builtin_amdgcn_global_load_lds((const unsigned*)((const char*)(gbase) + (voff)[_i]), (PG8_LAS unsigned*)(lds + (bufoff) + ldsw + _i * 8192), 16, 0, 0); } } while (0)
#define PG8_STA_CUR(b, h, kptr) do { if constexpr (GATHER) { PG8_STAGE_G(PG8_SA(b, h), kptr, gAc[h]); } else { PG8_STAGE(PG8_SA(b, h), (kptr) + (h) * hstep, voffA); } } while (0)
#define PG8_GROW(slot_, h, i) ((unsigned)S.arow(slot_, (h) * HALF + R0 + 64 * (i)) * (unsigned)RB + (unsigned)(C0 * 2))
#define PG8_STA_SEL(b, h, kptr, sel) do { if constexpr (GATHER) { unsigned _vo[2] = {(sel) ? gAn[h][0] : gAc[h][0], (sel) ? gAn[h][1] : gAc[h][1]}; PG8_STAGE_G(PG8_SA(b, h), kptr, _vo); } \
        else { PG8_STAGE(PG8_SA(b, h), (kptr) + (h) * hstep, voffA); } } while (0)
#define PG8_LDA(dst, b, h) do { _Pragma("unroll") for (int m = 0; m < 4; ++m) _Pragma("unroll") for (int k = 0; k < 2; ++k) dst[m][k] = *(const PG8_LAS bf16x8*)(lds + PG8_SA(b, h) + aoff + m * 2048 + k * 1024); } while (0)
#define PG8_LDB(dst, b, h) do { _Pragma("unroll") for (int n = 0; n < 2; ++n) _Pragma("unroll") for (int k = 0; k < 2; ++k) dst[n][k] = *(const PG8_LAS bf16x8*)(lds + PG8_SB(b, h) + boff + n * 2048 + k * 1024); } while (0)
#define PG8_MMA(ai, bj, At, Bt) do { __builtin_amdgcn_s_setprio(1); _Pragma("unroll") for (int m = 0; m < 4; ++m) _Pragma("unroll") for (int n = 0; n < 2; ++n) { \
        if constexpr (FP8) mfma_fp8(acc[ai][bj][m][n], cat16(Bt[n][0], Bt[n][1]), cat16(At[m][0], At[m][1]), sclW, sclA); \
        else { _Pragma("unroll") for (int k = 0; k < 2; ++k) acc[ai][bj][m][n] = __builtin_amdgcn_mfma_f32_16x16x32_bf16(Bt[n][k], At[m][k], acc[ai][bj][m][n], 0, 0, 0); } } __builtin_amdgcn_s_setprio(0); } while (0)
#define PG8_WAIT_V(n) asm volatile("s_waitcnt vmcnt(" #n ")" ::: "memory")
#define PG8_WAIT_L(n) asm volatile("s_waitcnt lgkmcnt(" #n ")" ::: "memory")
#define PG8_BAR __builtin_amdgcn_s_barrier()
#define PG8_SCHED __builtin_amdgcn_sched_barrier(0)
    Unit cur, nxt; int ui = 0;
    if (!S.next(0, cur)) return;
    int sclW = 0, sclA = 0; if constexpr (FP8) { sclW = Epi::SCALE_W; sclA = Epi::SCALE_A; asm volatile("" : "+v"(sclW), "+v"(sclA)); }
    unsigned gAc[2][2], gAn[2][2];
#pragma unroll
    for (int h = 0; h < 2; ++h)
#pragma unroll
        for (int i = 0; i < 2; ++i) { gAc[h][i] = GATHER ? PG8_GROW(cur.slot, h, i) : 0u; gAn[h][i] = gAc[h][i]; }
    f32x4 acc[2][2][4][2];
#pragma unroll
    for (int a = 0; a < 2; ++a)
#pragma unroll
        for (int b = 0; b < 2; ++b)
#pragma unroll
            for (int m = 0; m < 4; ++m)
#pragma unroll
                for (int n = 0; n < 2; ++n) acc[a][b][m][n] = (f32x4){0.f, 0.f, 0.f, 0.f};
    bf16x8 At[4][2], B0[2][2], B1[2][2];
    const char* cA = uniform_ptr(cur.A); const char* cB = uniform_ptr(cur.B);
    PG8_STAGE(PG8_SB(0, 0), cB, voffB); PG8_STAGE(PG8_SB(0, 1), cB + hstep, voffB); PG8_STA_CUR(0, 0, cA); PG8_STA_CUR(0, 1, cA);
    if (wr == 1) PG8_BAR;
    PG8_WAIT_V(2); PG8_BAR;
    PG8_STAGE(PG8_SB(1, 0), cB + kstep, voffB); PG8_STA_CUR(1, 0, cA + kstep); PG8_STAGE(PG8_SB(1, 1), cB + hstep + kstep, voffB);
    PG8_WAIT_V(6); PG8_BAR;
    for (;;) {
        const bool has_next = S.next(ui + 1, nxt);
        if constexpr (GATHER) { if (has_next) {
#pragma unroll
            for (int h = 0; h < 2; ++h)
#pragma unroll
                for (int i = 0; i < 2; ++i) gAn[h][i] = PG8_GROW(nxt.slot, h, i); } }
        const char* nA = uniform_ptr(has_next ? nxt.A : cA); const char* nB = uniform_ptr(has_next ? nxt.B : cB);
#pragma clang loop unroll(disable)
        for (int t = 0; t < nt; t += 2) {
            const bool last = (t == nt - 2);
            const bool seln = last && has_next;
            const char* a1 = cA + (size_t)(t + 1) * kstep;
            const char* a2 = last ? nA : cA + (size_t)(t + 2) * kstep; const char* b2 = last ? nB : cB + (size_t)(t + 2) * kstep;
            const char* a3 = a2 + kstep; const char* b3 = b2 + kstep;
            PG8_LDB(B0, 0, 0); PG8_LDB(B1, 0, 1); PG8_SCHED; PG8_LDA(At, 0, 0); PG8_STA_CUR(1, 1, a1);
            PG8_WAIT_V(8); PG8_WAIT_L(0); PG8_BAR; PG8_MMA(0, 0, At, B0); PG8_MMA(0, 1, At, B1); PG8_BAR; PG8_SCHED;
            PG8_LDA(At, 0, 1); PG8_STAGE(PG8_SB(0, 0), b2, voffB); PG8_STAGE(PG8_SB(0, 1), b2 + hstep, voffB); PG8_STA_SEL(0, 0, a2, seln);
            PG8_WAIT_V(8); PG8_WAIT_L(0); PG8_BAR; PG8_MMA(1, 0, At, B0); PG8_MMA(1, 1, At, B1); PG8_BAR; PG8_SCHED;
            PG8_LDB(B0, 1, 0); PG8_LDB(B1, 1, 1); PG8_SCHED; PG8_LDA(At, 1, 0); PG8_STA_SEL(0, 1, a2, seln);
            PG8_WAIT_V(8); PG8_WAIT_L(0); PG8_BAR; PG8_MMA(0, 0, At, B0); PG8_MMA(0, 1, At, B1); PG8_BAR; PG8_SCHED;
            PG8_LDA(At, 1, 1); PG8_STAGE(PG8_SB(1, 0), b3, voffB); PG8_STAGE(PG8_SB(1, 1), b3 + hstep, voffB); PG8_STA_SEL(1, 0, a3, seln);
            PG8_WAIT_V(8); PG8_WAIT_L(0); PG8_BAR; PG8_MMA(1, 0, At, B0); PG8_MMA(1, 1, At, B1); PG8_BAR; PG8_SCHED;
        }
        if constexpr (ALIGN_EPI) { if (wr == 0) PG8_BAR; }
        if constexpr (FP8) asm volatile("s_nop 15\n\ts_nop 7" ::: "memory");
        E(acc, cur, wr, wc, fr, fq);
        if (!has_next) break;
#pragma unroll
        for (int a = 0; a < 2; ++a)
#pragma unroll
            for (int b = 0; b < 2; ++b)
#pragma unroll
                for (int m = 0; m < 4; ++m)
#pragma unroll
                    for (int n = 0; n < 2; ++n) acc[a][b][m][n] = (f32x4){0.f, 0.f, 0.f, 0.f};
        cur = nxt; cA = nA; cB = nB; ++ui;
        if constexpr (GATHER) {
#pragma unroll
            for (int h = 0; h < 2; ++h)
#pragma unroll
                for (int i = 0; i < 2; ++i) gAc[h][i] = gAn[h][i]; }
        if constexpr (ALIGN_EPI) { if (wr == 1) PG8_BAR; }
    }
    PG8_WAIT_V(0);
    if constexpr (!ALIGN_EPI) { if (wr == 0) PG8_BAR; }
    PG8_BAR;
#undef PG8_SA
#undef PG8_SB
#undef PG8_STAGE
#undef PG8_STAGE_G
#undef PG8_DMA_S
#undef PG8_STA_CUR
#undef PG8_STA_SEL
#undef PG8_GROW
#undef PG8_LDA
#undef PG8_LDB
#undef PG8_MMA
#undef PG8_WAIT_V
#undef PG8_WAIT_L
#undef PG8_BAR
#undef PG8_SCHED
}
}

#ifndef REPMASK
#define REPMASK 0
#endif
namespace mk {
using pg8::bf16_t; using pg8::f32x4; using pg8::f32x2; using pg8::u32x4; using pg8::u32x2; using pg8::Unit; using pg8::cvt_pk_bf16; using pg8::bf_lo; using pg8::bf_hi; using pg8::sigm;
#define GAS __attribute__((address_space(1)))
#define LAS __attribute__((address_space(3)))
typedef GAS unsigned gu32;
#define RLX_AGENT __ATOMIC_RELAXED, __HIP_MEMORY_SCOPE_AGENT
#define LDS_WAIT() asm volatile("s_waitcnt lgkmcnt(0)" ::: "memory")
#define VM_WAIT() asm volatile("s_waitcnt vmcnt(0)" ::: "memory")

constexpr int NWAVES = 8;
constexpr int S = 16384, D = 1024, NE = 32, FF = 1024;
constexpr int ZP = 4352;
constexpr int C_QA = 0, C_KA = 512, C_VA = 640, C_QB = 768, C_KB = 1280, C_VB = 1792, C_GA = 2304, C_GB = 3328;
constexpr int W_FB = 2304;
constexpr int DIN = 4360;
constexpr float EPS = 1e-5f;
constexpr float LOG2E = 1.4426950408889634f;
constexpr float QSCALE = 0.125f * LOG2E;
constexpr int MAXSLOT = 65536 + 32 * 256;

constexpr size_t MiB = 1u << 20;
constexpr size_t WS_CTL = 0, CTL_ZERO_BYTES = 1 * MiB;
constexpr size_t WS_MOD = 1 * MiB;
constexpr size_t WS_TAB = WS_MOD + 32768;
constexpr size_t WS_BGL = WS_TAB + 8192;
constexpr size_t WS_LOGF = 2 * MiB;
constexpr size_t WS_CUM = 3 * MiB;
constexpr size_t WS_SEL = 4 * MiB;
constexpr size_t WS_LIST = 5 * MiB;
constexpr size_t WS_WIN = 8 * MiB;
constexpr size_t WS_WPA = 17 * MiB, WS_WPB = 18 * MiB;
constexpr size_t WS_WO = 19 * MiB;
constexpr size_t WS_U = 22 * MiB;
constexpr size_t WS_Z = 54 * MiB;
constexpr size_t WS_YAB = 190 * MiB;
constexpr size_t WS_TMP = 222 * MiB;
constexpr size_t WS_MRG = 254 * MiB;
constexpr size_t WS_X1 = 286 * MiB;
constexpr size_t WS_WE1 = 350 * MiB;
constexpr size_t WS_WE2 = 478 * MiB;
constexpr size_t WS_ACT = 542 * MiB;
constexpr size_t WS_Y = 686 * MiB;
constexpr size_t WS_END = 830 * MiB;
constexpr int CW_TMO = 0;
constexpr int CW_CNT = 64;
constexpr int CW_MODCNT = 192;
constexpr int CW_QUEUE = 128;
constexpr int CW_BAR = 4096;

constexpr int RING_OFF = 0, RING_BYTES = 131072;
constexpr int ROWTAB_OFF = 135168, ROWTAB_UNITS = 12;
constexpr int LDSCTL_OFF = 162816, MISC_OFF = LDSCTL_OFF + 320;
constexpr int LDS_BYTES = 163840;
static_assert(ROWTAB_OFF + ROWTAB_UNITS * 1024 <= LDSCTL_OFF && MISC_OFF + 128 <= LDS_BYTES, "LDS map");

__device__ __forceinline__ unsigned f2bf(float f) { unsigned u = __builtin_bit_cast(unsigned, f); return (u + 0x7fffu + ((u >> 16) & 1u)) >> 16; }
typedef float f32x2_t __attribute__((ext_vector_type(2))); typedef __bf16 bf16x2_t __attribute__((ext_vector_type(2)));
__device__ __forceinline__ unsigned pk2(float lo, float hi) { const f32x2_t v = {lo, hi}; const bf16x2_t b = __builtin_convertvector(v, bf16x2_t); return __builtin_bit_cast(unsigned, b); }
__device__ __forceinline__ unsigned pk_fp8x4(float a, float b, float c, float d) { int w = __builtin_amdgcn_cvt_pk_fp8_f32(a, b, 0, false); w = __builtin_amdgcn_cvt_pk_fp8_f32(c, d, w, true); return (unsigned)w; }
constexpr float W_SCALE = 64.0f, ACT_SCALE = 8.0f;
__device__ __forceinline__ float wave_sum(float v) {
#pragma unroll
    for (int o = 1; o < 64; o <<= 1) v += __shfl_xor(v, o);
    return v;
}

__device__ __forceinline__ int wave_min_i(int v) {
#pragma unroll
    for (int o = 1; o < 64; o <<= 1) { const int t = __shfl_xor(v, o); v = t < v ? t : v; }
    return v;
}
__device__ __forceinline__ float wave_max(float v) {
#pragma unroll
    for (int o = 1; o < 64; o <<= 1) v = fmaxf(v, __shfl_xor(v, o));
    return v;
}

#define XB_TMO      128
#define XB_XCNT(j)  (256  + 64 * (j))
#define XB_XSUB(j)  (1280 + 64 * (j))
#define XB_XGEN(j)  (2304 + 64 * (j))
#define XB_TOP      3328
#define XB_TOPGEN   3392
#define XCD_BAR_WORDS 3456
#define XB_SPIN_CAP (1u << 18)

__device__ __forceinline__ unsigned xb_ld(unsigned* p)              { return __hip_atomic_load(p, __ATOMIC_RELAXED, __HIP_MEMORY_SCOPE_AGENT); }
__device__ __forceinline__ unsigned xb_add(unsigned* p, unsigned v) { return __hip_atomic_fetch_add(p, v, __ATOMIC_RELAXED, __HIP_MEMORY_SCOPE_AGENT); }
__device__ __forceinline__ unsigned xb_xcc_id() { return (unsigned)__builtin_amdgcn_s_getreg((3 << 11) | 20) & 0xFu; }
#define XB_SPIN(cond, bar) do { unsigned _sp = 0; while (cond) { __builtin_amdgcn_s_sleep(1); \
    if ((++_sp & 255u) == 0u) { if (xb_ld(&(bar)[XB_TMO])) break; if (_sp > XB_SPIN_CAP) { atomicAdd(&(bar)[XB_TMO], 1u); break; } } } } while (0)

struct XcdBarrier {
    unsigned* bar; unsigned x;
    volatile LAS unsigned* st;
};

__device__ __forceinline__ XcdBarrier xcd_barrier_post(unsigned* bar, volatile LAS unsigned* st) {
    XcdBarrier b; b.bar = bar; b.x = xb_xcc_id(); b.st = st;
    if (threadIdx.x == 0) (void)xb_add(&bar[XB_XCNT(b.x)], 1u);
    return b;
}
__device__ __forceinline__ void xcd_barrier_complete(unsigned* bar, unsigned x, unsigned& nloc, unsigned& nx) {
    const unsigned G = gridDim.x * gridDim.y * gridDim.z;
    unsigned sum, cnt, mine, sp = 0u;
    for (;;) {
        sum = 0u; cnt = 0u; mine = 0u;
#pragma unroll
        for (unsigned j = 0; j < 16; ++j) { const unsigned c = xb_ld(&bar[XB_XCNT(j)]); sum += c; cnt += (c > 0u) ? 1u : 0u; mine = (j == x) ? c : mine; }
        if (sum == G) break;
        __builtin_amdgcn_s_sleep(1);
        if ((++sp & 255u) == 0u) { if (xb_ld(&bar[XB_TMO])) break; if (sp > XB_SPIN_CAP) { atomicAdd(&bar[XB_TMO], 1u); break; } }
    }
    nloc = mine > 0u ? mine : 1u; nx = cnt > 0u ? cnt : 1u;
}

__device__ __forceinline__ void xcd_barrier(const XcdBarrier& b) {
    asm volatile("s_waitcnt vmcnt(0)" ::: "memory");
    __syncthreads();
    if (threadIdx.x == 0) {
        unsigned* bar = b.bar;
        __builtin_amdgcn_s_waitcnt(0);
        unsigned nloc = b.st[0], nx = b.st[1];
        if (nloc == 0u) { xcd_barrier_complete(bar, b.x, nloc, nx); b.st[0] = nloc; b.st[1] = nx; }
        const unsigned old = xb_add(&bar[XB_XSUB(b.x)], 1u);
        const unsigned gen = old / nloc;
        if (old + 1u == (gen + 1u) * nloc) {
            __builtin_amdgcn_fence(__ATOMIC_RELEASE, "agent");
            asm volatile("s_waitcnt vmcnt(0)" ::: "memory");
            const unsigned og = xb_add(&bar[XB_TOP], 1u);
            const unsigned tg = og / nx;
            if (og + 1u == (tg + 1u) * nx) xb_add(&bar[XB_TOPGEN], 1u);
            else XB_SPIN(xb_ld(&bar[XB_TOPGEN]) == tg, bar);
            __builtin_amdgcn_fence(__ATOMIC_ACQUIRE, "agent");
            xb_add(&bar[XB_XGEN(b.x)], 1u);
            asm volatile("s_waitcnt vmcnt(0)" ::: "memory");
        } else {
            XB_SPIN(xb_ld(&bar[XB_XGEN(b.x)]) == gen, bar);
            __builtin_amdgcn_fence(__ATOMIC_ACQUIRE, "agent");
            asm volatile("s_waitcnt vmcnt(0)" ::: "memory");
        }
    }
    __syncthreads();
}

struct Frame {
    LAS unsigned char* lds;
    volatile LAS unsigned* MISC;
    gu32* ctl;
    int tid, lane, wave, vcu, G;
};

__device__ __forceinline__ void p0_small(Frame& F, const float* c, const float* w_ada, const float* b_ada, const float* rel, const float* b_e1, float* mod, float* tab, float* bgl) {
    LAS float* red = (LAS float*)(F.lds);
    for (int cg = blockIdx.x; cg < 256; cg += F.G) {
        const int col = F.tid % 24, kg = F.tid / 24;
        float acc = 0.f;
        if (kg < 21) { for (int k = kg; k < D; k += 21) { const float cv = c[k]; const float s = cv / (1.f + expf(-cv)); acc += s * w_ada[(size_t)k * 6144 + cg * 24 + col]; } red[kg * 24 + col] = acc; }
        __syncthreads();
        if (F.tid < 24) { float t = 0.f; for (int i = 0; i < 21; ++i) t += red[i * 24 + F.tid]; mod[cg * 24 + F.tid] = t + b_ada[cg * 24 + F.tid]; }
        __syncthreads();
        if (F.tid == 0) { __builtin_amdgcn_fence(__ATOMIC_RELEASE, "agent"); asm volatile("s_waitcnt vmcnt(0)" ::: "memory");
            __hip_atomic_fetch_add((unsigned*)(F.ctl + CW_MODCNT), 1u, __ATOMIC_RELAXED, __HIP_MEMORY_SCOPE_AGENT); }
    }
    if (blockIdx.x == 0) {
        for (int i = F.tid; i < 1024; i += NWAVES * 64) { const int h = i >> 7, n = i & 127; int bk;
            if (n < 16) bk = n; else { const int lg = 16 + (int)(logf((float)n / 16.f) / logf(8.f) * 16.f); bk = lg < 31 ? lg : 31; }
            tab[h * 128 + n] = rel[bk * 8 + h] * LOG2E; }
    }
    for (int i = blockIdx.x * (NWAVES * 64) + F.tid; i < NE * 2048; i += F.G * NWAVES * 64) {
        const int e = i >> 11, j = i & 2047; bgl[e * 2048 + (j & 1) * 1024 + (j >> 1)] = b_e1[i]; }
}

__device__ __forceinline__ void wait_mod(Frame& F) {
    if (F.tid == 0) { unsigned sp = 0;
        while (__hip_atomic_load((unsigned*)(F.ctl + CW_MODCNT), __ATOMIC_RELAXED, __HIP_MEMORY_SCOPE_AGENT) < 256u) { __builtin_amdgcn_s_sleep(2); if (++sp > (1u << 22)) { __hip_atomic_store((unsigned*)(F.ctl + CW_TMO), 1u, __ATOMIC_RELAXED, __HIP_MEMORY_SCOPE_AGENT); break; } }
        __builtin_amdgcn_fence(__ATOMIC_ACQUIRE, "agent"); asm volatile("s_waitcnt vmcnt(0)" ::: "memory"); }
    __syncthreads();
}
__device__ __forceinline__ void p1_rows(Frame& F, const float* x, const float* g, const float* mod, const float* w_in, const float* b_forget, bf16_t* U, float* logf_out) {
    LAS float* wf = (LAS float*)F.lds;
    for (int i = F.tid; i < 2048; i += NWAVES * 64) { const int k = i >> 1, hh = i & 1; const f32x4 t = *(const f32x4*)(w_in + (size_t)k * DIN + W_FB + hh * 4);
        wf[(hh * 4 + 0) * 1024 + k] = t.x; wf[(hh * 4 + 1) * 1024 + k] = t.y; wf[(hh * 4 + 2) * 1024 + k] = t.z; wf[(hh * 4 + 3) * 1024 + k] = t.w; }
    __syncthreads();
    f32x4 gv[4], sc1[4], sh[4];
#pragma unroll
    for (int j = 0; j < 4; ++j) { const int o = 4 * F.lane + 256 * j; gv[j] = *(const f32x4*)(g + o); sc1[j] = *(const f32x4*)(mod + 1024 + o) + 1.0f; sh[j] = *(const f32x4*)(mod + o); }
    const int gw = F.vcu * NWAVES + F.wave, NGW = F.G * NWAVES;
    const float bfv = b_forget[F.lane & 7];
    for (int m = gw; m < S; m += NGW) {
        const GAS f32x4* xr = (const GAS f32x4*)(x + (size_t)m * D) + F.lane;
        f32x4 v[4]; float ss = 0.f;
#pragma unroll
        for (int j = 0; j < 4; ++j) { v[j] = xr[64 * j]; ss += (v[j].x * v[j].x + v[j].y * v[j].y) + (v[j].z * v[j].z + v[j].w * v[j].w); }
        const float r = 1.0f / sqrtf(wave_sum(ss) * (1.f / D) + EPS);
        float fb[8];
#pragma unroll
        for (int h = 0; h < 8; ++h) fb[h] = 0.f;
        GAS unsigned long long* o8 = (GAS unsigned long long*)(U + (size_t)m * D) + F.lane;
#pragma unroll
        for (int j = 0; j < 4; ++j) {
            v[j] = v[j] * r * gv[j] * sc1[j] + sh[j];
            o8[64 * j] = (unsigned long long)pk2(v[j].x, v[j].y) | ((unsigned long long)pk2(v[j].z, v[j].w) << 32);
#pragma unroll
            for (int h = 0; h < 8; ++h) { const f32x4 w4 = *(const LAS f32x4*)(wf + h * 1024 + 4 * F.lane + 256 * j); fb[h] += (v[j].x * w4.x + v[j].y * w4.y) + (v[j].z * w4.z + v[j].w * w4.w); }
        }
#pragma unroll
        for (int h = 0; h < 8; ++h) fb[h] = wave_sum(fb[h]);
        float mine = fb[0];
#pragma unroll
        for (int h = 1; h < 8; ++h) mine = ((F.lane & 7) == h) ? fb[h] : mine;
        if (F.lane < 8) { const float xv = mine + bfv; logf_out[(size_t)m * 8 + F.lane] = fminf(xv, 0.f) - log1pf(expf(-fabsf(xv))); }
    }
    __syncthreads();
}
template <bool IL>
__device__ __forceinline__ void tr_item64(const float* W, int ldw, int sc0, int k0, bf16_t* WT, int K, int dr0, LAS unsigned char* scr, int lane) {
    const int r = lane >> 4, c = lane & 15;
    const float* src = W + (size_t)(k0 + 16 * r) * ldw + sc0 + 4 * c;
    f32x4 v[16];
#pragma unroll
    for (int i = 0; i < 16; ++i) v[i] = *(const f32x4*)(src + (size_t)i * ldw);
#pragma unroll
    for (int j = 0; j < 4; ++j) { u32x4 w0, w1;
        w0.x = cvt_pk_bf16(v[0][j], v[1][j]); w0.y = cvt_pk_bf16(v[2][j], v[3][j]); w0.z = cvt_pk_bf16(v[4][j], v[5][j]); w0.w = cvt_pk_bf16(v[6][j], v[7][j]);
        w1.x = cvt_pk_bf16(v[8][j], v[9][j]); w1.y = cvt_pk_bf16(v[10][j], v[11][j]); w1.z = cvt_pk_bf16(v[12][j], v[13][j]); w1.w = cvt_pk_bf16(v[14][j], v[15][j]);
        LAS unsigned char* d = scr + (4 * c + j) * 144 + r * 32; *(LAS u32x4*)d = w0; *(LAS u32x4*)(d + 16) = w1; }
    LDS_WAIT(); asm volatile("" ::: "memory");
#pragma unroll
    for (int q = 0; q < 8; ++q) { const int n = (lane >> 3) + 8 * q, ch = lane & 7; const u32x4 w = *(const LAS u32x4*)(scr + n * 144 + ch * 16);
        const int drow = IL ? dr0 + (n >> 1) + 128 * (n & 1) : dr0 + n;
        *(GAS u32x4*)(WT + (size_t)drow * K + k0 + 8 * ch) = w; }
    LDS_WAIT(); asm volatile("" ::: "memory");
}
template <bool IL>
__device__ __forceinline__ void tr_item_fp8(const float* W, int ldw, int sc0, int k0, unsigned char* WT, int K, int dr0, LAS unsigned char* scr, int lane) {
    const int r = lane >> 3, c = lane & 7;
    const float* src = W + (size_t)(k0 + 16 * r) * ldw + sc0 + 4 * c;
    f32x4 v[16];
#pragma unroll
    for (int i = 0; i < 16; ++i) v[i] = *(const f32x4*)(src + (size_t)i * ldw) * W_SCALE;
#pragma unroll
    for (int j = 0; j < 4; ++j) { u32x4 w;
        w.x = pk_fp8x4(v[0][j], v[1][j], v[2][j], v[3][j]); w.y = pk_fp8x4(v[4][j], v[5][j], v[6][j], v[7][j]); w.z = pk_fp8x4(v[8][j], v[9][j], v[10][j], v[11][j]); w.w = pk_fp8x4(v[12][j], v[13][j], v[14][j], v[15][j]);
        *(LAS u32x4*)(scr + (4 * c + j) * 144 + r * 16) = w; }
    LDS_WAIT(); asm volatile("" ::: "memory");
#pragma unroll
    for (int q = 0; q < 4; ++q) { const int n = (lane >> 3) + 8 * q, ch = lane & 7; const u32x4 w = *(const LAS u32x4*)(scr + n * 144 + ch * 16);
        const int drow = IL ? dr0 + (n >> 1) + 128 * (n & 1) : dr0 + n;
        *(GAS u32x4*)(WT + (size_t)drow * K + k0 + 16 * ch) = w; }
    LDS_WAIT(); asm volatile("" ::: "memory");
}
__device__ __forceinline__ void p1_weights(Frame& F, const float* w_in, const float* w_pa, const float* w_pb, const float* w_o, const float* w_e1, const float* w_e2,
                                           bf16_t* Win, bf16_t* Wpa, bf16_t* Wpb, bf16_t* Wo, unsigned char* We1, unsigned char* We2) {
    LAS unsigned char* scr = F.lds + F.wave * 9216;
    const int gw = F.vcu * NWAVES + F.wave, NGW = F.G * NWAVES;
    constexpr int I_E1 = NE * 8 * 64, I_E2 = NE * 8 * 32, I_IN = 16 * (ZP / 64), I_P = 8 * 16, I_O = 16 * 16;
    constexpr int NITEMS = I_E1 + I_E2 + I_IN + 2 * I_P + I_O;
    for (int it = gw; it < NITEMS; it += NGW) {
        int r = it;
        if (r < I_E1) { const int e = r >> 9, kb = (r & 511) >> 6, grp = r & 63;
            tr_item_fp8<true>(w_e1 + (size_t)e * D * 2048, 2048, 32 * grp, 128 * kb, We1 + (size_t)e * 2048 * D, D, 256 * (grp >> 3) + 16 * (grp & 7), scr, F.lane); continue; } r -= I_E1;
        if (r < I_E2) { const int e = r >> 8, kb = (r & 255) >> 5, nb = r & 31; tr_item_fp8<false>(w_e2 + (size_t)e * FF * D, D, 32 * nb, 128 * kb, We2 + (size_t)e * D * FF, FF, 32 * nb, scr, F.lane); continue; } r -= I_E2;
        if (r < I_IN) { const int kb = r / (ZP / 64), nb = r % (ZP / 64); const int sc0 = 64 * nb + (64 * nb >= W_FB ? 8 : 0); tr_item64<false>(w_in, DIN, sc0, 64 * kb, Win, D, 64 * nb, scr, F.lane); continue; } r -= I_IN;
        if (r < I_P) { tr_item64<false>(w_pa, D, 64 * (r & 15), 64 * (r >> 4), Wpa, 512, 64 * (r & 15), scr, F.lane); continue; } r -= I_P;
        if (r < I_P) { tr_item64<false>(w_pb, D, 64 * (r & 15), 64 * (r >> 4), Wpb, 512, 64 * (r & 15), scr, F.lane); continue; } r -= I_P;
        tr_item64<false>(w_o, D, 64 * (r & 15), 64 * (r >> 4), Wo, D, 64 * (r & 15), scr, F.lane);
    }
}

struct EpiInProj {
    static constexpr bool PERM = true;
    bf16_t* O;
    __device__ __forceinline__ void operator()(const f32x4 (&acc)[2][2][4][2], const Unit& u, int wr, int wc, int fr, int fq) const {
        const int row0 = u.pm * 256 + wr * 64 + fr, col0 = u.pn * 256 + wc * 32 + 8 * fq;
        const float sc = (u.pn < 2 || u.pn == 3 || u.pn == 4) ? QSCALE : 1.0f;
#pragma unroll
        for (int ai = 0; ai < 2; ++ai)
#pragma unroll
            for (int m = 0; m < 4; ++m) { bf16_t* rowp = O + (size_t)(row0 + ai * 128 + m * 16) * ZP + col0;
#pragma unroll
                for (int bj = 0; bj < 2; ++bj) { const f32x4 v0 = acc[ai][bj][m][0] * sc, v1 = acc[ai][bj][m][1] * sc;
                    u32x4 w; w.x = cvt_pk_bf16(v0[0], v0[1]); w.y = cvt_pk_bf16(v0[2], v0[3]); w.z = cvt_pk_bf16(v1[0], v1[1]); w.w = cvt_pk_bf16(v1[2], v1[3]);
                    *(u32x4*)(rowp + bj * 128) = w; } }
    }
};

__device__ __forceinline__ void p2b_cum(Frame& F, const float* logf_in, float* cum, int b0) {
    if ((int)blockIdx.x >= b0 && (int)blockIdx.x < b0 + 8) {
        const int h = (int)blockIdx.x - b0; LAS float* part = (LAS float*)F.lds;
        float lf[32]; float s = 0.f; const int t0 = F.tid * 32;
#pragma unroll
        for (int i = 0; i < 32; ++i) { lf[i] = logf_in[(size_t)(t0 + i) * 8 + h]; s += lf[i]; }
        part[F.tid] = s; __syncthreads();
        for (int o = 1; o < NWAVES * 64; o <<= 1) { const float v = (F.tid >= o) ? part[F.tid - o] : 0.f; __syncthreads(); part[F.tid] += v; __syncthreads(); }
        float run = part[F.tid] - s;
#pragma unroll
        for (int i = 0; i < 32; ++i) { run += lf[i]; cum[(size_t)h * S + t0 + i] = run * LOG2E; }
        __syncthreads();
    }
}

__device__ __forceinline__ void p2b_stats(Frame& F, const bf16_t* Z, float* QN, float* DG, float* KN) {
    const int gw = F.vcu * NWAVES + F.wave, NGW = F.G * NWAVES;
    for (int it = gw; it < 8 * (S / 64); it += NGW) {
        const int h = it >> 8, T = it & 255, t = 64 * T + F.lane;
        const u32x4* qp = (const u32x4*)(Z + (size_t)t * ZP + C_QB + h * 64); const u32x4* kp = (const u32x4*)(Z + (size_t)t * ZP + C_KB + h * 64);
        float qq = 0.f, kk = 0.f, qk = 0.f;
#pragma unroll
        for (int i = 0; i < 8; ++i) { const u32x4 a = qp[i], b = kp[i];
#pragma unroll
            for (int j = 0; j < 4; ++j) { const float a0 = bf_lo(a[j]), a1 = bf_hi(a[j]), b0 = bf_lo(b[j]), b1 = bf_hi(b[j]); qq += a0 * a0 + a1 * a1; kk += b0 * b0 + b1 * b1; qk += a0 * b0 + a1 * b1; } }
        QN[(size_t)h * S + t] = sqrtf(qq); DG[(size_t)h * S + t] = qk;
        const float km = wave_max(kk);
        if (F.lane == 0) KN[h * 256 + T] = sqrtf(km);
    }
}

namespace at {
typedef short bf16x8 __attribute__((ext_vector_type(8)));
typedef short s16x4 __attribute__((ext_vector_type(4)));
typedef short v4i16_t __attribute__((ext_vector_type(4)));
typedef float f32x16 __attribute__((ext_vector_type(16)));
constexpr int KBUF = 0, VBUF = 16384, CBUF = 32768  , BTAB = 36864  , QWORD = 37376;
__device__ __forceinline__ void glds16(const void* gsrc, unsigned lds_dst) { unsigned keep;
    asm volatile("s_mov_b32 %0, m0\n\ts_mov_b32 m0, %2\n\ts_nop 0\n\tglobal_load_lds_dwordx4 %1, off\n\ts_mov_b32 m0, %0" : "=&s"(keep) : "v"(gsrc), "s"(lds_dst) : "memory"); }
__device__ __forceinline__ void glds4(const void* gsrc, unsigned lds_dst) { unsigned keep;
    asm volatile("s_mov_b32 %0, m0\n\ts_mov_b32 m0, %2\n\ts_nop 0\n\tglobal_load_lds_dword %1, off\n\ts_mov_b32 m0, %0" : "=&s"(keep) : "v"(gsrc), "s"(lds_dst) : "memory"); }
#define AT_WAIT_BAR(N) asm volatile("s_waitcnt vmcnt(" #N ") lgkmcnt(0)\n\ts_barrier" ::: "memory")
__device__ __forceinline__ int crow(int r, int hi) { return (r & 3) + 8 * (r >> 2) + 4 * hi; }
__device__ __forceinline__ s16x4 vtr(const LAS char* p) { return __builtin_bit_cast(s16x4, __builtin_amdgcn_ds_read_tr16_b64_v4i16((LAS v4i16_t*)p)); }

template <bool FOX>
__device__ __forceinline__ void attn_unit(Frame& F, int h, int qb, int tfirst, int wfirst_fox, const bf16_t* Z, const float* cum, const float* tab, float sinkL2, bf16_t* Y) {
    const int lane = F.lane, r32 = lane & 31, hi = lane >> 5, wid = F.wave;
    const int q0 = qb * 256, qw0 = q0 + wid * 32, qrow = qw0 + r32;
    const int cq = FOX ? C_QB + h * 64 : C_QA + h * 64;
    const int ck = FOX ? C_KB + h * 64 : C_KA + (h >> 2) * 64;
    const int cv = FOX ? C_VB + h * 64 : C_VA + (h >> 2) * 64;
    const int tlast = (q0 + 255) >> 6;
    const int wlast = (qw0 + 31) >> 6;
    const int wfirst = FOX ? wfirst_fox : ((qw0 - 127 > 0 ? qw0 - 127 : 0) >> 6);
    const unsigned lds0 = (unsigned)(uintptr_t)F.lds;
    const LAS char* L = (const LAS char*)F.lds;
    if (!FOX) { if (F.tid < 128) ((LAS float*)(F.lds + BTAB))[F.tid] = tab[h * 128 + F.tid]; }
    bf16x8 qr[4];
#pragma unroll
    for (int d0 = 0; d0 < 4; ++d0) qr[d0] = *(const bf16x8*)(Z + (size_t)qrow * ZP + cq + d0 * 16 + hi * 8);
    const float ci = FOX ? cum[(size_t)h * S + qrow] : 0.f;
    asm volatile("s_waitcnt vmcnt(0)" ::: "memory");
    const bf16_t* ksrc = Z + (size_t)lane * ZP + ck + wid * 8;
    const bf16_t* vsrc = Z + (size_t)(16 * (wid & 3) + (lane >> 2)) * ZP + cv + (wid >> 2) * 32 + (lane & 3) * 8;
    const float* csrc = cum + (size_t)h * S + lane;
    const unsigned kdst = lds0 + KBUF + wid * 1024, vdst = lds0 + VBUF + wid * 1024, cdst = lds0 + CBUF + wid * 256;
#define AT_ISSUE(t, b) do { glds16(ksrc + (size_t)(t) * 64 * ZP, (unsigned)__builtin_amdgcn_readfirstlane(kdst + (b) * 8192)); glds16(vsrc + (size_t)(t) * 64 * ZP, (unsigned)__builtin_amdgcn_readfirstlane(vdst + (b) * 8192)); \
        if (FOX) glds4(csrc + (size_t)(t) * 64, (unsigned)__builtin_amdgcn_readfirstlane(cdst + (b) * 2048)); } while (0)
    float m = FOX ? 0.f : sinkL2, l = FOX ? 0.f : (hi == 0 ? 1.f : 0.f), cinit = ci - m;
    bool first = FOX;
    f32x16 o[2]; o[0] = f32x16{}; o[1] = f32x16{};
    AT_ISSUE(tlast, 0);
    for (int t = tlast; t >= tfirst; --t) {
        const int b = (tlast - t) & 1;
        if (t > tfirst) { AT_ISSUE(t - 1, b ^ 1); if (FOX) AT_WAIT_BAR(3); else AT_WAIT_BAR(2); } else AT_WAIT_BAR(0);
        if (t >= wfirst && t <= wlast) {
            const LAS char* Kb = L + KBUF + b * 8192; const LAS char* Vb = L + VBUF + b * 8192;
            f32x16 p0, p1;
#pragma unroll
            for (int r = 0; r < 16; ++r) { p0[r] = cinit; p1[r] = cinit; }
#pragma unroll
            for (int d0 = 0; d0 < 4; ++d0) {
                const bf16x8 a0 = *(const LAS bf16x8*)(Kb + (2 * d0 + hi) * 1024 + r32 * 16);
                const bf16x8 a1 = *(const LAS bf16x8*)(Kb + (2 * d0 + hi) * 1024 + r32 * 16 + 512);
                p0 = __builtin_amdgcn_mfma_f32_32x32x16_bf16(a0, qr[d0], p0, 0, 0, 0);
                p1 = __builtin_amdgcn_mfma_f32_32x32x16_bf16(a1, qr[d0], p1, 0, 0, 0);
            }
            const int kv0 = 64 * t;
            if (FOX) {
                const LAS float* cb = (const LAS float*)(L + CBUF + b * 2048 + wid * 256);
#pragma unroll
                for (int g = 0; g < 4; ++g) { const f32x4 c0 = *(const LAS f32x4*)(cb + 8 * g + 4 * hi), c1 = *(const LAS f32x4*)(cb + 32 + 8 * g + 4 * hi);
#pragma unroll
                    for (int i = 0; i < 4; ++i) { p0[4 * g + i] -= c0[i]; p1[4 * g + i] -= c1[i]; } }
                if (kv0 + 63 > qw0) {
#pragma unroll
                    for (int r = 0; r < 16; ++r) { const int kv = kv0 + crow(r, hi); if (kv > qrow) p0[r] = -INFINITY; if (kv + 32 > qrow) p1[r] = -INFINITY; }
                }
            } else {
                const LAS float* bt = (const LAS float*)(L + BTAB);
#pragma unroll
                for (int r = 0; r < 16; ++r) { const int d0_ = qrow - (kv0 + crow(r, hi)), d1_ = d0_ - 32;
                    const bool ok0 = (unsigned)d0_ < 128u, ok1 = (unsigned)d1_ < 128u;
                    const float b0 = bt[ok0 ? d0_ : 0], b1 = bt[ok1 ? d1_ : 0];
                    p0[r] = ok0 ? p0[r] + b0 : -INFINITY; p1[r] = ok1 ? p1[r] + b1 : -INFINITY; }
            }
            float ra = fmaxf(fmaxf(p0[0], p0[1]), p1[0]), rb = fmaxf(fmaxf(p0[2], p0[3]), p1[1]); ra = fmaxf(fmaxf(ra, p1[2]), p1[3]);
#pragma unroll
            for (int r = 4; r < 16; r += 4) { ra = fmaxf(fmaxf(ra, p0[r]), p0[r + 1]); rb = fmaxf(fmaxf(rb, p0[r + 2]), p0[r + 3]); ra = fmaxf(fmaxf(ra, p1[r]), p1[r + 1]); rb = fmaxf(fmaxf(rb, p1[r + 2]), p1[r + 3]); }
            float rm = fmaxf(ra, rb);
            rm = fmaxf(rm, __shfl_xor(rm, 32));
            if (first || __any(rm > 0.f)) {
                const float dl = first ? rm : fmaxf(rm, 0.f), f = first ? 0.f : __builtin_amdgcn_exp2f(-dl);
                m += dl; cinit -= dl; l *= f;
#pragma unroll
                for (int r = 0; r < 16; ++r) { p0[r] -= dl; p1[r] -= dl; o[0][r] *= f; o[1][r] *= f; }
                first = false;
            }
            float ls = 0.f;
#pragma unroll
            for (int r = 0; r < 16; ++r) { p0[r] = __builtin_amdgcn_exp2f(p0[r]); p1[r] = __builtin_amdgcn_exp2f(p1[r]); ls += p0[r] + p1[r]; }
            l += ls;
            bf16x8 pw[4];
#pragma unroll
            for (int s = 0; s < 4; ++s) { u32x4 w;
#pragma unroll
                for (int j = 0; j < 4; ++j) { const float lo = (s < 2) ? p0[8 * (s & 1) + 2 * j] : p1[8 * (s & 1) + 2 * j], hi_ = (s < 2) ? p0[8 * (s & 1) + 2 * j + 1] : p1[8 * (s & 1) + 2 * j + 1]; w[j] = pk2(lo, hi_); }
                pw[s] = __builtin_bit_cast(bf16x8, w); }
            const LAS char* vp = Vb + ((lane >> 4) & 1) * 32 + (lane & 3) * 8 + (4 * hi + ((lane & 15) >> 2)) * 64;
#pragma unroll
            for (int dh = 0; dh < 2; ++dh)
#pragma unroll
                for (int s = 0; s < 4; ++s) { const s16x4 vlo = vtr(vp + dh * 4096 + s * 1024), vhi = vtr(vp + dh * 4096 + s * 1024 + 512);
                    const bf16x8 vf = (bf16x8){vlo[0], vlo[1], vlo[2], vlo[3], vhi[0], vhi[1], vhi[2], vhi[3]};
                    o[dh] = __builtin_amdgcn_mfma_f32_32x32x16_bf16(vf, pw[s], o[dh], 0, 0, 0); }
        }
        asm volatile("s_waitcnt lgkmcnt(0)\n\ts_barrier" ::: "memory");
    }
#undef AT_ISSUE
    l += __shfl_xor(l, 32);
    const float il = 1.0f / l;
    bf16_t* yrow = Y + (FOX ? (size_t)S * 512 : 0) + (size_t)qrow * 512 + h * 64;
#pragma unroll
    for (int dh = 0; dh < 2; ++dh)
#pragma unroll
        for (int g = 0; g < 4; ++g) { u32x2 w; w.x = pk2(o[dh][4 * g] * il, o[dh][4 * g + 1] * il); w.y = pk2(o[dh][4 * g + 2] * il, o[dh][4 * g + 3] * il);
            *(u32x2*)(yrow + dh * 32 + 8 * g + 4 * hi) = w; }
}

constexpr float FOX_THR = 44.0f;
__device__ __forceinline__ void attn_phase(Frame& F, const bf16_t* Z, const float* cum, const float* tab, const float* sinks, const float* QN, const float* DG, const float* KN, bf16_t* Y, int qsel = 0) {
    volatile LAS unsigned* qw = (volatile LAS unsigned*)(F.lds + QWORD);
    for (;;) {
        if (F.tid == 0) *qw = __hip_atomic_fetch_add((unsigned*)(F.ctl + CW_QUEUE + 64 * qsel), 1u, __ATOMIC_RELAXED, __HIP_MEMORY_SCOPE_AGENT);
        __syncthreads();
        const unsigned u = *qw;
        __syncthreads();
        if (u >= 1024u) break;
        if (u < 512u) {
            const int h = (int)(u & 7u), qb = 63 - (int)(u >> 3), q0 = qb * 256;
            volatile LAS int* red = (volatile LAS int*)(F.lds + QWORD + 64);
            const size_t o = (size_t)h * S + q0 + 32 * F.wave + (F.lane & 31);
            const float qn = wave_max(QN[o]), ev = wave_max(cum[o] - DG[o]);
            int myt = q0 >> 6;
            for (int T = F.lane; T < (q0 >> 6); T += 64) { const float ub = qn * KN[h * 256 + T] - cum[(size_t)h * S + 64 * T + 63] + ev; if (!(ub < -(FOX_THR + 1.0f))) myt = T < myt ? T : myt; }
            myt = wave_min_i(myt);
            if (F.lane == 0) red[F.wave] = myt;
            __syncthreads();
            int tf = red[0];
#pragma unroll
            for (int w = 1; w < 8; ++w) { const int t = red[w]; tf = t < tf ? t : tf; }
            __syncthreads();
            attn_unit<true>(F, h, qb, tf, myt, Z, cum, tab, 0.f, Y);
        }
        else { const unsigned v = u - 512u; const int h = (int)(v & 7u), qb = (int)(v >> 3); const int q0t = qb * 4 - 2; attn_unit<false>(F, h, qb, q0t < 0 ? 0 : q0t, 0, Z, cum, tab, sinks[h] * LOG2E, Y); }
    }
}
#undef AT_WAIT_BAR
}

template <int MODE> struct EpiMerge {
    static constexpr bool PERM = true;
    const bf16_t* Z; bf16_t* T; bf16_t* O; int gcol; int pad;
    __device__ __forceinline__ void operator()(const f32x4 (&acc)[2][2][4][2], const Unit& u, int wr, int wc, int fr, int fq) const {
        const int row0 = u.pm * 256 + wr * 64 + fr, col0 = u.pn * 256 + wc * 32 + 8 * fq;
#pragma unroll
        for (int ai = 0; ai < 2; ++ai)
#pragma unroll
            for (int m = 0; m < 4; ++m) { const size_t row = (size_t)(row0 + ai * 128 + m * 16);
#pragma unroll
                for (int bj = 0; bj < 2; ++bj) { const int col = col0 + bj * 128;
                    const u32x4 g = *(const u32x4*)(Z + row * ZP + gcol + col);
                    const f32x4 v0 = acc[ai][bj][m][0], v1 = acc[ai][bj][m][1];
                    float r[8];
                    r[0] = sigm(bf_lo(g.x)) * v0[0]; r[1] = sigm(bf_hi(g.x)) * v0[1]; r[2] = sigm(bf_lo(g.y)) * v0[2]; r[3] = sigm(bf_hi(g.y)) * v0[3];
                    r[4] = sigm(bf_lo(g.z)) * v1[0]; r[5] = sigm(bf_hi(g.z)) * v1[1]; r[6] = sigm(bf_lo(g.w)) * v1[2]; r[7] = sigm(bf_hi(g.w)) * v1[3];
                    if (MODE == 1) { const u32x4 t = *(const u32x4*)(T + row * 1024 + col);
                        r[0] += bf_lo(t.x); r[1] += bf_hi(t.x); r[2] += bf_lo(t.y); r[3] += bf_hi(t.y); r[4] += bf_lo(t.z); r[5] += bf_hi(t.z); r[6] += bf_lo(t.w); r[7] += bf_hi(t.w); }
                    u32x4 w; w.x = cvt_pk_bf16(r[0], r[1]); w.y = cvt_pk_bf16(r[2], r[3]); w.z = cvt_pk_bf16(r[4], r[5]); w.w = cvt_pk_bf16(r[6], r[7]);
                    *(u32x4*)((MODE == 0 ? T : O) + row * 1024 + col) = w; } }
    }
};
struct EpiResid {
    static constexpr bool PERM = false;
    const float* X; const float* gate; float* O;
    __device__ __forceinline__ void operator()(const f32x4 (&acc)[2][2][4][2], const Unit& u, int wr, int wc, int fr, int fq) const {
        const int row0 = u.pm * 256 + wr * 64 + fr, col0 = u.pn * 256 + wc * 32 + 4 * fq;
#pragma unroll
        for (int bj = 0; bj < 2; ++bj)
#pragma unroll
            for (int n = 0; n < 2; ++n) { const int col = col0 + bj * 128 + n * 16; const f32x4 gv = *(const f32x4*)(gate + col);
#pragma unroll
                for (int ai = 0; ai < 2; ++ai)
#pragma unroll
                    for (int m = 0; m < 4; ++m) { const size_t off = (size_t)(row0 + ai * 128 + m * 16) * D + col;
                        *(f32x4*)(O + off) = *(const f32x4*)(X + off) + gv * acc[ai][bj][m][n]; } }
    }
};

__device__ __forceinline__ float reduce_scatter32(const float (&a)[32], int lane) {
    float a16[16], a8[8], a4[4], a2[2];
    const bool b5 = lane & 32, b4 = lane & 16, b3 = lane & 8, b2 = lane & 4, b1 = lane & 2;
#pragma unroll
    for (int i = 0; i < 16; ++i) { const float keep = b5 ? a[i + 16] : a[i], send = b5 ? a[i] : a[i + 16]; a16[i] = keep + __shfl_xor(send, 32); }
#pragma unroll
    for (int i = 0; i < 8; ++i) { const float keep = b4 ? a16[i + 8] : a16[i], send = b4 ? a16[i] : a16[i + 8]; a8[i] = keep + __shfl_xor(send, 16); }
#pragma unroll
    for (int i = 0; i < 4; ++i) { const float keep = b3 ? a8[i + 4] : a8[i], send = b3 ? a8[i] : a8[i + 4]; a4[i] = keep + __shfl_xor(send, 8); }
#pragma unroll
    for (int i = 0; i < 2; ++i) { const float keep = b2 ? a4[i + 2] : a4[i], send = b2 ? a4[i] : a4[i + 2]; a2[i] = keep + __shfl_xor(send, 4); }
    const float keep = b1 ? a2[1] : a2[0], send = b1 ? a2[0] : a2[1];
    float v = keep + __shfl_xor(send, 2);
    v += __shfl_xor(v, 1);
    return v;
}
__device__ __forceinline__ void p6_route(Frame& F, const float* X1, const float* g, const float* mod, const float* w_router, const float* b_router, unsigned char* U2, int* sel_ep, float* sel_w, int* list) {
    LAS float* wr = (LAS float*)F.lds;
    LAS int* selE = (LAS int*)(F.lds + ROWTAB_OFF);
    LAS int* lcnt = (LAS int*)(F.lds + LDSCTL_OFF);
    LAS int* gbase = lcnt + 32;
    for (int i = F.tid; i < 32768; i += NWAVES * 64) wr[(i & 31) * 1024 + (i >> 5)] = w_router[i];
    if (F.tid < 64) lcnt[F.tid] = 0;
    f32x4 gv[4], sc1[4], sh[4];
#pragma unroll
    for (int j = 0; j < 4; ++j) { const int o = 4 * F.lane + 256 * j; gv[j] = *(const f32x4*)(g + o); sc1[j] = *(const f32x4*)(mod + 4096 + o) + 1.0f; sh[j] = *(const f32x4*)(mod + 3072 + o); }
    const float brv = b_router[F.lane >> 1];
    __syncthreads();
    const int gw = F.vcu * NWAVES + F.wave, NGW = F.G * NWAVES;
    int it = 0;
    for (int rp6 = 0; rp6 < ((REPMASK & 0x40000) ? 2 : 1); ++rp6) { it = 0;
    for (int m = gw; m < S; m += NGW, ++it) {
        const GAS f32x4* xr = (const GAS f32x4*)(X1 + (size_t)m * D) + F.lane;
        f32x4 v[4]; float ss = 0.f;
#pragma unroll
        for (int j = 0; j < 4; ++j) { v[j] = xr[64 * j]; ss += (v[j].x * v[j].x + v[j].y * v[j].y) + (v[j].z * v[j].z + v[j].w * v[j].w); }
        const float r = 1.0f / sqrtf(wave_sum(ss) * (1.f / D) + EPS);
        GAS unsigned* o4 = (GAS unsigned*)(U2 + (size_t)m * D) + F.lane;
#pragma unroll
        for (int j = 0; j < 4; ++j) { v[j] = v[j] * r * gv[j] * sc1[j] + sh[j];
            o4[64 * j] = pk_fp8x4(v[j].x, v[j].y, v[j].z, v[j].w); }
        float acc[32];
#pragma unroll
        for (int e = 0; e < 32; ++e) { float a = 0.f;
#pragma unroll
            for (int j = 0; j < 4; ++j) { const f32x4 w4 = *(const LAS f32x4*)(wr + e * 1024 + 4 * F.lane + 256 * j); a += (v[j].x * w4.x + v[j].y * w4.y) + (v[j].z * w4.z + v[j].w * w4.w); }
            acc[e] = a; }
        float lv = reduce_scatter32(acc, F.lane) + brv;
        float tv[4]; int te[4];
#pragma unroll
        for (int k = 0; k < 4; ++k) { const float mx = wave_max(lv); const unsigned long long bal = __ballot(lv == mx); const int e = (__ffsll((long long)bal) - 1) >> 1;
            tv[k] = mx; te[k] = e; if ((F.lane >> 1) == e) lv = -INFINITY; }
        float p[4], sum = 0.f;
#pragma unroll
        for (int k = 0; k < 4; ++k) { p[k] = expf(tv[k] - tv[0]); sum += p[k]; }
        if (F.lane < 4) { float pw = p[0]; int ew = te[0];
#pragma unroll
            for (int k = 1; k < 4; ++k) { pw = (F.lane == k) ? p[k] : pw; ew = (F.lane == k) ? te[k] : ew; }
            sel_w[(size_t)m * 4 + F.lane] = pw / sum; selE[(it * NWAVES + F.wave) * 4 + F.lane] = ew; }
    } }
    __syncthreads();
    const int nrows = it * NWAVES;
    int myE[2], myL[2];
#pragma unroll
    for (int q = 0; q < 2; ++q) { const int t = F.tid + q * NWAVES * 64; myE[q] = 0; myL[q] = 0; if (t < nrows * 4) { myE[q] = selE[t]; myL[q] = __hip_atomic_fetch_add(&lcnt[myE[q]], 1, __ATOMIC_RELAXED, __HIP_MEMORY_SCOPE_WORKGROUP); } }
    __syncthreads();
    if (F.tid < 32) gbase[F.tid] = (int)__hip_atomic_fetch_add((unsigned*)(F.ctl + CW_CNT + F.tid), (unsigned)lcnt[F.tid], __ATOMIC_RELAXED, __HIP_MEMORY_SCOPE_AGENT);
    __syncthreads();
#pragma unroll
    for (int q = 0; q < 2; ++q) { const int t = F.tid + q * NWAVES * 64; if (t < nrows * 4) { const int rl = t >> 2, e = myE[q], pos = gbase[e] + myL[q];
        const int tok = (F.vcu * NWAVES + (rl & 7)) + (rl >> 3) * NGW; list[(size_t)e * S + pos] = tok; sel_ep[(size_t)tok * 4 + (t & 3)] = (e << 16) | pos; } }
    __syncthreads();
}

__device__ __forceinline__ void moe_tables(Frame& F) {
    LAS int* tp = (LAS int*)(F.lds + LDSCTL_OFF);
    LAS int* cn = tp + 40;
    if (F.tid == 0) { int t = 0; for (int e = 0; e < NE; ++e) { const int c = (int)__hip_atomic_load((unsigned*)(F.ctl + CW_CNT + e), __ATOMIC_RELAXED, __HIP_MEMORY_SCOPE_AGENT); tp[e] = t; cn[e] = c; t += (c + 255) >> 8; } tp[NE] = t; }
    __syncthreads();
}
template <bool GATHER> struct MoeOrder {
    const LAS int* tp; const LAS int* rowtab; const char* A; const char* Bt; size_t bstride; int NT, RB, U, per, nb, x, rank;
    __device__ void init(Frame& F, const void* A_, const void* Bt_, size_t bstride_, int NT_, int RB_) {
        tp = (const LAS int*)(F.lds + LDSCTL_OFF); rowtab = (const LAS int*)(F.lds + ROWTAB_OFF); A = (const char*)A_; Bt = (const char*)Bt_; bstride = bstride_; NT = NT_; RB = RB_;
        U = tp[NE] * NT;
        if (F.G % 8 == 0) { nb = F.G >> 3; x = blockIdx.x & 7; rank = blockIdx.x >> 3; per = (U + 7) >> 3; } else { nb = F.G; x = 0; rank = blockIdx.x; per = U; }
    }
    __device__ bool next(int i, Unit& u) const {
        const int p = i * nb + rank; if (p >= per) return false;
        const int id = x * per + p; if (id >= U) return false;
        const int mtg = id / NT, nt = id - mtg * NT;
        int e = 0; while (tp[e + 1] <= mtg) ++e;
        e = __builtin_amdgcn_readfirstlane(e);
        u.pm = mtg; u.pn = nt; u.e = e; u.slot = i;
        u.A = pg8::uniform_ptr(GATHER ? A : A + (size_t)mtg * 256 * RB); u.B = pg8::uniform_ptr(Bt + (size_t)e * bstride + (size_t)nt * 256 * RB); return true;
    }
    __device__ __forceinline__ int arow(int slot, int r) const { return rowtab[slot * 256 + r]; }
};
__device__ __forceinline__ void moe_rowtab(Frame& F, const MoeOrder<true>& So, const int* list) {
    const LAS int* tp = (const LAS int*)(F.lds + LDSCTL_OFF); const LAS int* cn = tp + 40;
    LAS int* rowtab = (LAS int*)(F.lds + ROWTAB_OFF);
    Unit u;
    for (int i = 0; i < ROWTAB_UNITS && So.next(i, u); ++i) {
        if (F.tid < 256) { const int pos = (u.pm - tp[u.e]) * 256 + F.tid; rowtab[i * 256 + F.tid] = list[(size_t)u.e * S + (pos < cn[u.e] ? pos : 0)]; }
    }
    __syncthreads();
}
struct EpiMoe1 {
    static constexpr bool PERM = true; static constexpr int SCALE_W = 0x79797979  , SCALE_A = 0x7f7f7f7f;
    const float* bgl; unsigned char* ACT;
    __device__ __forceinline__ void operator()(const f32x4 (&acc)[2][2][4][2], const Unit& u, int wr, int wc, int fr, int fq) const {
        const int row0 = u.pm * 256 + wr * 64 + fr, acol = u.pn * 128 + wc * 32 + 8 * fq;
        const float* bg = bgl + (size_t)u.e * 2048 + acol;
        const f32x4 bg0 = *(const f32x4*)bg, bg1 = *(const f32x4*)(bg + 4), bl0 = *(const f32x4*)(bg + 1024), bl1 = *(const f32x4*)(bg + 1028);
#pragma unroll
        for (int ai = 0; ai < 2; ++ai)
#pragma unroll
            for (int m = 0; m < 4; ++m) { const size_t row = (size_t)(row0 + ai * 128 + m * 16);
                const f32x4 g0 = acc[ai][0][m][0] + bg0, g1 = acc[ai][0][m][1] + bg1, l0 = acc[ai][1][m][0] + bl0, l1 = acc[ai][1][m][1] + bl1;
                float r[8];
#pragma unroll
                for (int i = 0; i < 4; ++i) { const float ga = fminf(g0[i], 7.0f), la = fminf(fmaxf(l0[i], -7.0f), 7.0f), gb = fminf(g1[i], 7.0f), lb = fminf(fmaxf(l1[i], -7.0f), 7.0f);
                    r[i] = ga * sigm(1.702f * ga) * (la + 1.0f) * ACT_SCALE; r[4 + i] = gb * sigm(1.702f * gb) * (lb + 1.0f) * ACT_SCALE; }
                u32x2 w; w.x = pk_fp8x4(r[0], r[1], r[2], r[3]); w.y = pk_fp8x4(r[4], r[5], r[6], r[7]);
                *(u32x2*)(ACT + row * FF + acol) = w; }
    }
};
struct EpiMoe2 {
    static constexpr bool PERM = true; static constexpr int SCALE_W = 0x79797979  , SCALE_A = 0x7c7c7c7c  ;
    const float* b2; bf16_t* Y;
    __device__ __forceinline__ void operator()(const f32x4 (&acc)[2][2][4][2], const Unit& u, int wr, int wc, int fr, int fq) const {
        const int row0 = u.pm * 256 + wr * 64 + fr, col0 = u.pn * 256 + wc * 32 + 8 * fq;
        f32x4 bv[2][2];
#pragma unroll
        for (int bj = 0; bj < 2; ++bj)
#pragma unroll
            for (int n = 0; n < 2; ++n) bv[bj][n] = *(const f32x4*)(b2 + (size_t)u.e * D + col0 + bj * 128 + 4 * n);
#pragma unroll
        for (int ai = 0; ai < 2; ++ai)
#pragma unroll
            for (int m = 0; m < 4; ++m) { bf16_t* rowp = Y + (size_t)(row0 + ai * 128 + m * 16) * D + col0;
#pragma unroll
                for (int bj = 0; bj < 2; ++bj) { const f32x4 v0 = acc[ai][bj][m][0] + bv[bj][0], v1 = acc[ai][bj][m][1] + bv[bj][1];
                    u32x4 w; w.x = cvt_pk_bf16(v0[0], v0[1]); w.y = cvt_pk_bf16(v0[2], v0[3]); w.z = cvt_pk_bf16(v1[0], v1[1]); w.w = cvt_pk_bf16(v1[2], v1[3]);
                    *(u32x4*)(rowp + bj * 128) = w; } }
    }
};

__device__ __forceinline__ void p9_final(Frame& F, const float* X1, const bf16_t* Y, const float* gate, const float* g, const int* sel_ep, const float* sel_w, float* out) {
    const LAS int* tp = (const LAS int*)(F.lds + LDSCTL_OFF);
    f32x4 gv[4], gt[4];
#pragma unroll
    for (int j = 0; j < 4; ++j) { const int o = 4 * F.lane + 256 * j; gv[j] = *(const f32x4*)(g + o); gt[j] = *(const f32x4*)(gate + o); }
    const int gw = F.vcu * NWAVES + F.wave, NGW = F.G * NWAVES;
    for (int m = gw; m < S; m += NGW) {
        f32x4 mo[4];
#pragma unroll
        for (int j = 0; j < 4; ++j) mo[j] = (f32x4){0.f, 0.f, 0.f, 0.f};
#pragma unroll
        for (int k = 0; k < 4; ++k) { const int ep = sel_ep[(size_t)m * 4 + k]; const float w = sel_w[(size_t)m * 4 + k]; const int slot = tp[ep >> 16] * 256 + (ep & 0xffff);
            const GAS u32x2* yr = (const GAS u32x2*)(Y + (size_t)slot * D) + F.lane;
#pragma unroll
            for (int j = 0; j < 4; ++j) { const u32x2 t = yr[64 * j]; mo[j] += w * (f32x4){bf_lo(t.x), bf_hi(t.x), bf_lo(t.y), bf_hi(t.y)}; } }
        const GAS f32x4* xr = (const GAS f32x4*)(X1 + (size_t)m * D) + F.lane;
        f32x4 v[4]; float ss = 0.f;
#pragma unroll
        for (int j = 0; j < 4; ++j) { v[j] = xr[64 * j] + gt[j] * mo[j]; ss += (v[j].x * v[j].x + v[j].y * v[j].y) + (v[j].z * v[j].z + v[j].w * v[j].w); }
        const float r = 1.0f / sqrtf(wave_sum(ss) * (1.f / D) + EPS);
        GAS f32x4* orow = (GAS f32x4*)(out + (size_t)m * D) + F.lane;
#pragma unroll
        for (int j = 0; j < 4; ++j) orow[64 * j] = v[j] * r * gv[j];
    }
}

struct Args { const float* in[20]; float* out; unsigned char* ws; int ph_lo, ph_hi; };
enum { PH_SMALL = 0, PH_ROWS, PH_INPROJ, PH_CUM, PH_ATTN, PH_MERGE, PH_WO, PH_ROUTE, PH_MOE1, PH_MOE2, PH_FINAL, PH_COUNT };

__global__ void __launch_bounds__(NWAVES * 64, 2) mk_fwd(Args args) {
    extern __shared__ __attribute__((aligned(16))) unsigned char lds[];
    Frame F;
    F.lds = (LAS unsigned char*)lds;
    F.MISC = (volatile LAS unsigned*)(F.lds + MISC_OFF);
    F.tid = threadIdx.x; F.lane = F.tid & 63; F.wave = __builtin_amdgcn_readfirstlane(F.tid >> 6);
    F.G = gridDim.x; { const int bx = blockIdx.x; F.vcu = (F.G % 8 == 0) ? (bx % 8) * (F.G / 8) + bx / 8 : bx; }
    unsigned char* ws = args.ws;
    F.ctl = (gu32*)(ws + WS_CTL);
    for (int u = F.tid; u < (LDS_BYTES - LDSCTL_OFF) / 4; u += NWAVES * 64) ((LAS unsigned*)(F.lds + LDSCTL_OFF))[u] = 0u;
    __syncthreads();
    XcdBarrier bar = xcd_barrier_post((unsigned*)(F.ctl + CW_BAR), F.MISC + 8);
    const int lo = args.ph_lo, hi = args.ph_hi;
#ifndef REPMASK
#define REPMASK 0
#endif
#define IN(k) (lo <= (k) && (k) < hi)
#define REPS(k) (((REPMASK >> (k)) & 1) ? 2 : 1)
#define REPEAT(k, ...) { __VA_ARGS__ if (REPS(k) == 2) { __VA_ARGS__ } }
#define SEAM(k) do { if (IN((k) + 1)) xcd_barrier(bar); } while (0)
    const float* x = args.in[0]; const float* c = args.in[1]; const float* w_ada = args.in[2]; const float* b_ada = args.in[3]; const float* g_mix = args.in[4]; const float* w_in = args.in[5];
    const float* b_forget = args.in[6]; const float* sinks = args.in[7]; const float* rel = args.in[8]; const float* w_pa = args.in[9]; const float* w_pb = args.in[10]; const float* w_o = args.in[11];
    const float* g_ffn = args.in[12]; const float* w_router = args.in[13]; const float* b_router = args.in[14]; const float* w_e1 = args.in[15]; const float* b_e1 = args.in[16];
    const float* w_e2 = args.in[17]; const float* b_e2 = args.in[18]; const float* g_final = args.in[19];
    float* mod = (float*)(ws + WS_MOD); float* tab = (float*)(ws + WS_TAB); float* bgl = (float*)(ws + WS_BGL); float* logfb = (float*)(ws + WS_LOGF); float* cum = (float*)(ws + WS_CUM);
    bf16_t* Win = (bf16_t*)(ws + WS_WIN); bf16_t* Wpa = (bf16_t*)(ws + WS_WPA); bf16_t* Wpb = (bf16_t*)(ws + WS_WPB); bf16_t* Wo = (bf16_t*)(ws + WS_WO);
    unsigned char* We1 = ws + WS_WE1; unsigned char* We2 = ws + WS_WE2;
    bf16_t* U = (bf16_t*)(ws + WS_U); bf16_t* Z = (bf16_t*)(ws + WS_Z);

    if (IN(PH_SMALL)) { p0_small(F, c, w_ada, b_ada, rel, b_e1, mod, tab, bgl); }
    if (IN(PH_ROWS)) { p1_weights(F, w_in, w_pa, w_pb, w_o, w_e1, w_e2, Win, Wpa, Wpb, Wo, We1, We2); __syncthreads(); wait_mod(F); p1_rows(F, x, g_mix, mod, w_in, b_forget, U, logfb); SEAM(PH_ROWS); }
    if (IN(PH_INPROJ)) {
        pg8::DenseOrder So; So.init(U, Win, S, ZP, D, F.G, (int)blockIdx.x);
        EpiInProj E{Z};
        REPEAT(PH_INPROJ, pg8::gemm_phase<EpiInProj, pg8::DenseOrder, true, false>(F.lds + RING_OFF, D, So, E);)
        if (F.G == 256) p2b_cum(F, logfb, cum, 64);
        SEAM(PH_INPROJ);
    }
    if (IN(PH_CUM)) { if (F.G != 256) p2b_cum(F, logfb, cum, 0); p2b_stats(F, Z, (float*)(ws + WS_TMP), (float*)(ws + WS_TMP) + 8 * S, (float*)(ws + WS_TMP) + 16 * S); SEAM(PH_CUM); }
    bf16_t* YAB = (bf16_t*)(ws + WS_YAB); bf16_t* TMP = (bf16_t*)(ws + WS_TMP); bf16_t* MRG = (bf16_t*)(ws + WS_MRG); float* X1 = (float*)(ws + WS_X1);
    if (IN(PH_ATTN)) { at::attn_phase(F, Z, cum, tab, sinks, (const float*)(ws + WS_TMP), (const float*)(ws + WS_TMP) + 8 * S, (const float*)(ws + WS_TMP) + 16 * S, YAB); if (REPS(PH_ATTN) == 2) at::attn_phase(F, Z, cum, tab, sinks, (const float*)(ws + WS_TMP), (const float*)(ws + WS_TMP) + 8 * S, (const float*)(ws + WS_TMP) + 16 * S, YAB, 1); SEAM(PH_ATTN); }
    if (IN(PH_MERGE)) { REPEAT(PH_MERGE,
        { pg8::DenseOrder So; So.init(YAB, Wpa, S, D, 512, F.G, (int)blockIdx.x); EpiMerge<0> E{Z, TMP, MRG, C_GA, 0};
          pg8::gemm_phase<EpiMerge<0>, pg8::DenseOrder, true, false>(F.lds + RING_OFF, 512, So, E); }
        { pg8::DenseOrder So; So.init(YAB + (size_t)S * 512, Wpb, S, D, 512, F.G, (int)blockIdx.x); EpiMerge<1> E{Z, TMP, MRG, C_GB, 0};
          pg8::gemm_phase<EpiMerge<1>, pg8::DenseOrder, true, false>(F.lds + RING_OFF, 512, So, E); } )
        SEAM(PH_MERGE);
    }
    if (IN(PH_WO)) {
        pg8::DenseOrder So; So.init(MRG, Wo, S, D, D, F.G, (int)blockIdx.x); EpiResid E{x, mod + 2048, X1};
        REPEAT(PH_WO, pg8::gemm_phase<EpiResid, pg8::DenseOrder, true, false>(F.lds + RING_OFF, D, So, E);)
        SEAM(PH_WO);
    }
    int* sel_ep = (int*)(ws + WS_SEL); float* sel_w = (float*)(ws + WS_SEL + 262144); int* list = (int*)(ws + WS_LIST);
    unsigned char* ACT = ws + WS_ACT; bf16_t* Y = (bf16_t*)(ws + WS_Y); unsigned char* U8 = ws + WS_U;
    if (IN(PH_ROUTE)) { p6_route(F, X1, g_ffn, mod, w_router, b_router, U8, sel_ep, sel_w, list); SEAM(PH_ROUTE); }
    if (IN(PH_MOE1)) {
        moe_tables(F); MoeOrder<true> So; So.init(F, U8, We1, (size_t)2048 * D, 8, D); moe_rowtab(F, So, list);
        EpiMoe1 E{bgl, ACT};
        REPEAT(PH_MOE1, pg8::gemm_phase<EpiMoe1, MoeOrder<true>, true, true, true>(F.lds + RING_OFF, D, So, E);)
        SEAM(PH_MOE1);
    }
    if (IN(PH_MOE2)) {
        moe_tables(F); MoeOrder<false> So; So.init(F, ACT, We2, (size_t)D * FF, 4, FF);
        EpiMoe2 E{b_e2, Y};
        REPEAT(PH_MOE2, pg8::gemm_phase<EpiMoe2, MoeOrder<false>, true, false, true>(F.lds + RING_OFF, FF, So, E);)
        SEAM(PH_MOE2);
    }
    if (IN(PH_FINAL)) { moe_tables(F); REPEAT(PH_FINAL, p9_final(F, X1, Y, mod + 5120, g_final, sel_ep, sel_w, args.out);) }

#undef IN
#undef SEAM
}
}


extern "C" void kernel_launch(void* const* d_in, const int* in_sizes, int n_in, void* d_out, int out_size, void* d_ws, size_t ws_size, hipStream_t stream) {
    static int grid = 0;
    if (grid == 0) {
        int dev = 0, cus = 0;
        if (n_in != 20 || out_size != mk::S * mk::D || ws_size < mk::WS_END) { fprintf(stderr, "kernel_launch: unexpected shapes / workspace (%d inputs, out %d, ws %zu)\n", n_in, out_size, ws_size); grid = -1; return; }
        if (hipGetDevice(&dev) != hipSuccess || hipDeviceGetAttribute(&cus, hipDeviceAttributeMultiprocessorCount, dev) != hipSuccess) { grid = -1; return; }
        if (hipFuncSetAttribute((const void*)mk::mk_fwd, hipFuncAttributeMaxDynamicSharedMemorySize, mk::LDS_BYTES) != hipSuccess) { fprintf(stderr, "hipFuncSetAttribute failed\n"); grid = -1; return; }
        int per_cu = 0;
        if (hipOccupancyMaxActiveBlocksPerMultiprocessor(&per_cu, (const void*)mk::mk_fwd, mk::NWAVES * 64, mk::LDS_BYTES) != hipSuccess || per_cu < 1) { fprintf(stderr, "occupancy query: %d\n", per_cu); (void)hipGetLastError(); grid = -1; return; }
        grid = cus;
        if (mk::S % (grid * mk::NWAVES) != 0 || grid % 8 != 0) { fprintf(stderr, "kernel_launch: built for a CU count that divides %d rows evenly (got %d)\n", mk::S, cus); grid = -1; return; }
    }
    if (grid < 0) return;
    (void)hipMemsetAsync((char*)d_ws + mk::WS_CTL, 0, mk::CTL_ZERO_BYTES, stream);
    mk::Args a{};
    for (int i = 0; i < 20; ++i) a.in[i] = (const float*)d_in[i];
    a.out = (float*)d_out; a.ws = (unsigned char*)d_ws; a.ph_lo = 0; a.ph_hi = mk::PH_COUNT;
    hipLaunchKernelGGL(mk::mk_fwd, dim3(grid), dim3(mk::NWAVES * 64), mk::LDS_BYTES, stream, a);
}
```

```cpp
#include <hip/hip_runtime.h>
#include <cstdint>
#include <cstdio>
#include <cmath>


namespace pg8 {
#define PG8_LAS __attribute__((address_space(3)))
typedef unsigned short bf16_t;
typedef short bf16x8 __attribute__((ext_vector_type(8)));
typedef float f32x4 __attribute__((ext_vector_type(4)));
typedef float f32x2 __attribute__((ext_vector_type(2)));
typedef unsigned u32x4 __attribute__((ext_vector_type(4)));
typedef unsigned u32x2 __attribute__((ext_vector_type(2)));
constexpr int BM = 256, BK = 64, HALF = 128, HTB = HALF * BK * 2  , STAGE_BYTES = 8 * HTB, NXCD = 8, WGM = 8;

__host__ __device__ __forceinline__ int lds_byte(int r, int c) { const int st = (r >> 4) * 2 + (c >> 5), rr = r & 15, cc = c & 31, ob = rr * 64 + cc * 2; return st * 1024 + (ob ^ (((ob >> 9) & 1) << 5)); }
__host__ __device__ __forceinline__ void stage_rc(int b, int& R, int& C) { const int st = b / 1024, sb = b % 1024, swz = sb ^ (((sb >> 9) & 1) << 5); R = (st >> 1) * 16 + swz / 64; C = (st & 1) * 32 + (swz % 64) / 2; }
__host__ __device__ __forceinline__ int perm32(int rho) { const int n = rho >> 4, i = rho & 15; return 8 * (i >> 2) + 4 * n + (i & 3); }

struct Unit { const char* A; const char* B; int pm, pn, e, slot; };
__device__ __forceinline__ const char* uniform_ptr(const char* p) { const unsigned long long v = (unsigned long long)p; const unsigned lo = __builtin_amdgcn_readfirstlane((unsigned)v), hi = __builtin_amdgcn_readfirstlane((unsigned)(v >> 32)); return (const char*)(((unsigned long long)hi << 32) | lo); }

struct DenseOrder {
    const char* A; const char* Bt; int nM, nN, nwg, G, c, K;
    __device__ void init(const void* A_, const void* Bt_, int M, int N, int K_, int G_, int c_) { A = (const char*)A_; Bt = (const char*)Bt_; nM = M / BM; nN = N / BM; nwg = nM * nN; G = G_; c = c_; K = K_; }
    __device__ bool next(int i, Unit& u) const {
        const long L = (long)i * G + c; if (L >= nwg) return false;
        int wgid = (int)L; { const int q = nwg / NXCD, r = nwg % NXCD, xcd = wgid % NXCD, off = wgid / NXCD; wgid = (xcd < r ? xcd * (q + 1) : r * (q + 1) + (xcd - r) * q) + off; }
        const int nig = WGM * nN, gid = wgid / nig, fm = gid * WGM, gsz = (nM - fm) < WGM ? (nM - fm) : WGM;
        u.pm = fm + ((wgid % nig) % gsz); u.pn = (wgid % nig) / gsz; u.e = 0; u.slot = 0;
        u.A = A + (size_t)u.pm * BM * K * 2; u.B = Bt + (size_t)u.pn * BM * K * 2; return true;
    }
    __device__ __forceinline__ int arow(int, int) const { return 0; }
};

__device__ __forceinline__ unsigned cvt_pk_bf16(float lo, float hi) { unsigned r; asm volatile("v_cvt_pk_bf16_f32 %0, %1, %2" : "=v"(r) : "v"(lo), "v"(hi)); return r; }
__device__ __forceinline__ float bf_lo(unsigned w) { return __uint_as_float(w << 16); }
__device__ __forceinline__ float bf_hi(unsigned w) { return __uint_as_float(w & 0xffff0000u); }
__device__ __forceinline__ float sigm(float x) { return __builtin_amdgcn_rcpf(1.f + __expf(-x)); }

typedef int v4i_t __attribute__((ext_vector_type(4)));
typedef int v8i_t __attribute__((ext_vector_type(8)));
__device__ __forceinline__ v8i_t cat16(bf16x8 a, bf16x8 b) { const v4i_t x = __builtin_bit_cast(v4i_t, a), y = __builtin_bit_cast(v4i_t, b); return __builtin_shufflevector(x, y, 0, 1, 2, 3, 4, 5, 6, 7); }
__device__ __forceinline__ void mfma_fp8(f32x4& acc, v8i_t a, v8i_t b, int sa, int sb) {
    asm volatile("v_mfma_scale_f32_16x16x128_f8f6f4 %0, %1, %2, %0, %3, %4 op_sel_hi:[0,0,0]" : "+v"(acc) : "v"(a), "v"(b), "v"(sa), "v"(sb)); }
template <class Epi, class Sched, bool ALIGN_EPI, bool GATHER, bool FP8 = false>
__device__ __forceinline__ void gemm_phase(PG8_LAS unsigned char* lds, const int K, const Sched& S, const Epi& E) {
    const int tid = threadIdx.x, wid = __builtin_amdgcn_readfirstlane(tid >> 6), lane = tid & 63, wr = wid >> 2, wc = wid & 3, fr = lane & 15, fq = lane >> 4;
    const int RB = FP8 ? K : K * 2;
    const int nt = RB / 128;
    unsigned voffA[2], voffB[2]; int R0, C0;
    { stage_rc(tid * 16, R0, C0); const int Rb = Epi::PERM ? ((R0 & ~31) + perm32(R0 & 31)) : R0;
      voffA[0] = (unsigned)(R0 * RB + C0 * 2); voffB[0] = (unsigned)(Rb * RB + C0 * 2); voffA[1] = voffA[0] + 64u * (unsigned)RB; voffB[1] = voffB[0] + 64u * (unsigned)RB; }
    const size_t kstep = (size_t)(BK * 2);
    const size_t hstep = (size_t)HALF * RB;
    const unsigned ldsw = (unsigned)wid * 1024u;
    const int aoff = lds_byte(wr * 64 + fr, fq * 8), boff = lds_byte(wc * 32 + fr, fq * 8);
#define PG8_SA(b, h) (((b) * 2 + (h)) * HTB)
#define PG8_SB(b, h) ((4 + (b) * 2 + (h)) * HTB)
    const unsigned ldsu = (unsigned)(uintptr_t)lds + ldsw;
#define PG8_DMA_S(sbase, voff_, ldsaddr) do { unsigned _keep; asm volatile("s_mov_b32 %0, m0\n\ts_mov_b32 m0, %3\n\ts_nop 0\n\tglobal_load_lds_dwordx4 %2, %1\n\ts_mov_b32 m0, %0" : "=&s"(_keep) : "s"((const char*)(sbase)), "v"(voff_), "s"(ldsaddr) : "memory"); } while (0)
#define PG8_STAGE(bufoff, gbase, voff) do { _Pragma("unroll") for (int _i = 0; _i < 2; ++_i) { \
        if constexpr (FP8) PG8_DMA_S((const char*)(gbase) + (size_t)_i * 64 * RB, (voff)[0], ldsu + (unsigned)((bufoff) + _i * 8192)); \
        else __builtin_amdgcn_global_load_lds((const unsigned*)((const char*)(gbase) + (voff)[_i]), (PG8_LAS unsigned*)(lds + (bufoff) + ldsw + _i * 8192), 16, 0, 0); } } while (0)
#define PG8_STAGE_G(bufoff, gbase, voff) do { _Pragma("unroll") for (int _i = 0; _i < 2; ++_i) { \
        if constexpr (FP8) PG8_DMA_S((const char*)(gbase), (voff)[_i], ldsu + (unsigned)((bufoff) + _i * 8192)); \
        else __builtin_amdgcn_global_load_lds((const unsigned*)((const char*)(gbase) + (voff)[_i]), (PG8_LAS unsigned*)(lds + (bufoff) + ldsw + _i * 8192), 16, 0, 0); } } while (0)
#define PG8_STA_CUR(b, h, kptr) do { if constexpr (GATHER) { PG8_STAGE_G(PG8_SA(b, h), kptr, gAc[h]); } else { PG8_STAGE(PG8_SA(b, h), (kptr) + (h) * hstep, voffA); } } while (0)
#define PG8_GROW(slot_, h, i) ((unsigned)S.arow(slot_, (h) * HALF + R0 + 64 * (i)) * (unsigned)RB + (unsigned)(C0 * 2))
#define PG8_STA_SEL(b, h, kptr, sel) do { if constexpr (GATHER) { unsigned _vo[2] = {(sel) ? gAn[h][0] : gAc[h][0], (sel) ? gAn[h][1] : gAc[h][1]}; PG8_STAGE_G(PG8_SA(b, h), kptr, _vo); } \
        else { PG8_STAGE(PG8_SA(b, h), (kptr) + (h) * hstep, voffA); } } while (0)
#define PG8_LDA(dst, b, h) do { _Pragma("unroll") for (int m = 0; m < 4; ++m) _Pragma("unroll") for (int k = 0; k < 2; ++k) dst[m][k] = *(const PG8_LAS bf16x8*)(lds + PG8_SA(b, h) + aoff + m * 2048 + k * 1024); } while (0)
#define PG8_LDB(dst, b, h) do { _Pragma("unroll") for (int n = 0; n < 2; ++n) _Pragma("unroll") for (int k = 0; k < 2; ++k) dst[n][k] = *(const PG8_LAS bf16x8*)(lds + PG8_SB(b, h) + boff + n * 2048 + k * 1024); } while (0)
#define PG8_MMA(ai, bj, At, Bt) do { __builtin_amdgcn_s_setprio(1); _Pragma("unroll") for (int m = 0; m < 4; ++m) _Pragma("unroll") for (int n = 0; n < 2; ++n) { \
        if constexpr (FP8) mfma_fp8(acc[ai][bj][m][n], cat16(Bt[n][0], Bt[n][1]), cat16(At[m][0], At[m][1]), sclW, sclA); \
        else { _Pragma("unroll") for (int k = 0; k < 2; ++k) acc[ai][bj][m][n] = __builtin_amdgcn_mfma_f32_16x16x32_bf16(Bt[n][k], At[m][k], acc[ai][bj][m][n], 0, 0, 0); } } __builtin_amdgcn_s_setprio(0); } while (0)
#define PG8_WAIT_V(n) asm volatile("s_waitcnt vmcnt(" #n ")" ::: "memory")
#define PG8_WAIT_L(n) asm volatile("s_waitcnt lgkmcnt(" #n ")" ::: "memory")
#define PG8_BAR __builtin_amdgcn_s_barrier()
#define PG8_SCHED __builtin_amdgcn_sched_barrier(0)
    Unit cur, nxt; int ui = 0;
    if (!S.next(0, cur)) return;
    int sclW = 0, sclA = 0; if constexpr (FP8) { sclW = Epi::SCALE_W; sclA = Epi::SCALE_A; asm volatile("" : "+v"(sclW), "+v"(sclA)); }
    unsigned gAc[2][2], gAn[2][2];
#pragma unroll
    for (int h = 0; h < 2; ++h)
#pragma unroll
        for (int i = 0; i < 2; ++i) { gAc[h][i] = GATHER ? PG8_GROW(cur.slot, h, i) : 0u; gAn[h][i] = gAc[h][i]; }
    f32x4 acc[2][2][4][2];
#pragma unroll
    for (int a = 0; a < 2; ++a)
#pragma unroll
        for (int b = 0; b < 2; ++b)
#pragma unroll
            for (int m = 0; m < 4; ++m)
#pragma unroll
                for (int n = 0; n < 2; ++n) acc[a][b][m][n] = (f32x4){0.f, 0.f, 0.f, 0.f};
    bf16x8 At[4][2], B0[2][2], B1[2][2];
    const char* cA = uniform_ptr(cur.A); const char* cB = uniform_ptr(cur.B);
    PG8_STAGE(PG8_SB(0, 0), cB, voffB); PG8_STAGE(PG8_SB(0, 1), cB + hstep, voffB); PG8_STA_CUR(0, 0, cA); PG8_STA_CUR(0, 1, cA);
    if (wr == 1) PG8_BAR;
    PG8_WAIT_V(2); PG8_BAR;
    PG8_STAGE(PG8_SB(1, 0), cB + kstep, voffB); PG8_STA_CUR(1, 0, cA + kstep); PG8_STAGE(PG8_SB(1, 1), cB + hstep + kstep, voffB);
    PG8_WAIT_V(6); PG8_BAR;
    for (;;) {
        const bool has_next = S.next(ui + 1, nxt);
        if constexpr (GATHER) { if (has_next) {
#pragma unroll
            for (int h = 0; h < 2; ++h)
#pragma unroll
                for (int i = 0; i < 2; ++i) gAn[h][i] = PG8_GROW(nxt.slot, h, i); } }
        const char* nA = uniform_ptr(has_next ? nxt.A : cA); const char* nB = uniform_ptr(has_next ? nxt.B : cB);
#pragma clang loop unroll(disable)
        for (int t = 0; t < nt; t += 2) {
            const bool last = (t == nt - 2);
            const bool seln = last && has_next;
            const char* a1 = cA + (size_t)(t + 1) * kstep;
            const char* a2 = last ? nA : cA + (size_t)(t + 2) * kstep; const char* b2 = last ? nB : cB + (size_t)(t + 2) * kstep;
            const char* a3 = a2 + kstep; const char* b3 = b2 + kstep;
            PG8_LDB(B0, 0, 0); PG8_LDB(B1, 0, 1); PG8_SCHED; PG8_LDA(At, 0, 0); PG8_STA_CUR(1, 1, a1);
            PG8_WAIT_V(8); PG8_WAIT_L(0); PG8_BAR; PG8_MMA(0, 0, At, B0); PG8_MMA(0, 1, At, B1); PG8_BAR; PG8_SCHED;
            PG8_LDA(At, 0, 1); PG8_STAGE(PG8_SB(0, 0), b2, voffB); PG8_STAGE(PG8_SB(0, 1), b2 + hstep, voffB); PG8_STA_SEL(0, 0, a2, seln);
            PG8_WAIT_V(8); PG8_WAIT_L(0); PG8_BAR; PG8_MMA(1, 0, At, B0); PG8_MMA(1, 1, At, B1); PG8_BAR; PG8_SCHED;
            PG8_LDB(B0, 1, 0); PG8_LDB(B1, 1, 1); PG8_SCHED; PG8_LDA(At, 1, 0); PG8_STA_SEL(0, 1, a2, seln);
            PG8_WAIT_V(8); PG8_WAIT_L(0); PG8_BAR; PG8_MMA(0, 0, At, B0); PG8_MMA(0, 1, At, B1); PG8_BAR; PG8_SCHED;
            PG8_LDA(At, 1, 1); PG8_STAGE(PG8_SB(1, 0), b3, voffB); PG8_STAGE(PG8_SB(1, 1), b3 + hstep, voffB); PG8_STA_SEL(1, 0, a3, seln);
            PG8_WAIT_V(8); PG8_WAIT_L(0); PG8_BAR; PG8_MMA(1, 0, At, B0); PG8_MMA(1, 1, At, B1); PG8_BAR; PG8_SCHED;
        }
        if constexpr (ALIGN_EPI) { if (wr == 0) PG8_BAR; }
        if constexpr (FP8) asm volatile("s_nop 15\n\ts_nop 7" ::: "memory");
        E(acc, cur, wr, wc, fr, fq);
        if (!has_next) break;
#pragma unroll
        for (int a = 0; a < 2; ++a)
#pragma unroll
            for (int b = 0; b < 2; ++b)
#pragma unroll
                for (int m = 0; m < 4; ++m)
#pragma unroll
                    for (int n = 0; n < 2; ++n) acc[a][b][m][n] = (f32x4){0.f, 0.f, 0.f, 0.f};
        cur = nxt; cA = nA; cB = nB; ++ui;
        if constexpr (GATHER) {
#pragma unroll
            for (int h = 0; h < 2; ++h)
#pragma unroll
                for (int i = 0; i < 2; ++i) gAc[h][i] = gAn[h][i]; }
        if constexpr (ALIGN_EPI) { if (wr == 1) PG8_BAR; }
    }
    PG8_WAIT_V(0);
    if constexpr (!ALIGN_EPI) { if (wr == 0) PG8_BAR; }
    PG8_BAR;
#undef PG8_SA
#undef PG8_SB
#undef PG8_STAGE
#undef PG8_STAGE_G
#undef PG8_DMA_S
#undef PG8_STA_CUR
#undef PG8_STA_SEL
#undef PG8_GROW
#undef PG8_LDA
#undef PG8_LDB
#undef PG8_MMA
#undef PG8_WAIT_V
#undef PG8_WAIT_L
#undef PG8_BAR
#undef PG8_SCHED
}
}

#ifndef REPMASK
#define REPMASK 0
#endif
namespace mk {
using pg8::bf16_t; using pg8::f32x4; using pg8::f32x2; using pg8::u32x4; using pg8::u32x2; using pg8::Unit; using pg8::cvt_pk_bf16; using pg8::bf_lo; using pg8::bf_hi; using pg8::sigm;
#define GAS __attribute__((address_space(1)))
#define LAS __attribute__((address_space(3)))
typedef GAS unsigned gu32;
#define RLX_AGENT __ATOMIC_RELAXED, __HIP_MEMORY_SCOPE_AGENT
#define LDS_WAIT() asm volatile("s_waitcnt lgkmcnt(0)" ::: "memory")
#define VM_WAIT() asm volatile("s_waitcnt vmcnt(0)" ::: "memory")

constexpr int NWAVES = 8;
constexpr int S = 16384, D = 1024, NE = 32, FF = 1024;
constexpr int ZP = 4352;
constexpr int C_QA = 0, C_KA = 512, C_VA = 640, C_QB = 768, C_KB = 1280, C_VB = 1792, C_GA = 2304, C_GB = 3328;
constexpr int W_FB = 2304;
constexpr int DIN = 4360;
constexpr float EPS = 1e-5f;
constexpr float LOG2E = 1.4426950408889634f;
constexpr float QSCALE = 0.125f * LOG2E;
constexpr int MAXSLOT = 65536 + 32 * 256;

constexpr size_t MiB = 1u << 20;
constexpr size_t WS_CTL = 0, CTL_ZERO_BYTES = 1 * MiB;
constexpr size_t WS_MOD = 1 * MiB;
constexpr size_t WS_TAB = WS_MOD + 32768;
constexpr size_t WS_BGL = WS_TAB + 8192;
constexpr size_t WS_LOGF = 2 * MiB;
constexpr size_t WS_CUM = 3 * MiB;
constexpr size_t WS_SEL = 4 * MiB;
constexpr size_t WS_LIST = 5 * MiB;
constexpr size_t WS_WIN = 8 * MiB;
constexpr size_t WS_WPA = 17 * MiB, WS_WPB = 18 * MiB;
constexpr size_t WS_WO = 19 * MiB;
constexpr size_t WS_U = 22 * MiB;
constexpr size_t WS_Z = 54 * MiB;
constexpr size_t WS_YAB = 190 * MiB;
constexpr size_t WS_TMP = 222 * MiB;
constexpr size_t WS_MRG = 254 * MiB;
constexpr size_t WS_X1 = 286 * MiB;
constexpr size_t WS_WE1 = 350 * MiB;
constexpr size_t WS_WE2 = 478 * MiB;
constexpr size_t WS_ACT = 542 * MiB;
constexpr size_t WS_Y = 686 * MiB;
constexpr size_t WS_END = 830 * MiB;
constexpr int CW_TMO = 0;
constexpr int CW_CNT = 64;
constexpr int CW_MODCNT = 192;
constexpr int CW_QUEUE = 128;
constexpr int CW_BAR = 4096;

constexpr int RING_OFF = 0, RING_BYTES = 131072;
constexpr int ROWTAB_OFF = 135168, ROWTAB_UNITS = 12;
constexpr int LDSCTL_OFF = 162816, MISC_OFF = LDSCTL_OFF + 320;
constexpr int LDS_BYTES = 163840;
static_assert(ROWTAB_OFF + ROWTAB_UNITS * 1024 <= LDSCTL_OFF && MISC_OFF + 128 <= LDS_BYTES, "LDS map");

__device__ __forceinline__ unsigned f2bf(float f) { unsigned u = __builtin_bit_cast(unsigned, f); return (u + 0x7fffu + ((u >> 16) & 1u)) >> 16; }
typedef float f32x2_t __attribute__((ext_vector_type(2))); typedef __bf16 bf16x2_t __attribute__((ext_vector_type(2)));
__device__ __forceinline__ unsigned pk2(float lo, float hi) { const f32x2_t v = {lo, hi}; const bf16x2_t b = __builtin_convertvector(v, bf16x2_t); return __builtin_bit_cast(unsigned, b); }
__device__ __forceinline__ unsigned pk_fp8x4(float a, float b, float c, float d) { int w = __builtin_amdgcn_cvt_pk_fp8_f32(a, b, 0, false); w = __builtin_amdgcn_cvt_pk_fp8_f32(c, d, w, true); return (unsigned)w; }
constexpr float W_SCALE = 64.0f, ACT_SCALE = 8.0f;
__device__ __forceinline__ float wave_sum(float v) {
#pragma unroll
    for (int o = 1; o < 64; o <<= 1) v += __shfl_xor(v, o);
    return v;
}

__device__ __forceinline__ int wave_min_i(int v) {
#pragma unroll
    for (int o = 1; o < 64; o <<= 1) { const int t = __shfl_xor(v, o); v = t < v ? t : v; }
    return v;
}
__device__ __forceinline__ float wave_max(float v) {
#pragma unroll
    for (int o = 1; o < 64; o <<= 1) v = fmaxf(v, __shfl_xor(v, o));
    return v;
}

#define XB_TMO      128
#define XB_XCNT(j)  (256  + 64 * (j))
#define XB_XSUB(j)  (1280 + 64 * (j))
#define XB_XGEN(j)  (2304 + 64 * (j))
#define XB_TOP      3328
#define XB_TOPGEN   3392
#define XCD_BAR_WORDS 3456
#define XB_SPIN_CAP (1u << 18)

__device__ __forceinline__ unsigned xb_ld(unsigned* p)              { return __hip_atomic_load(p, __ATOMIC_RELAXED, __HIP_MEMORY_SCOPE_AGENT); }
__device__ __forceinline__ unsigned xb_add(unsigned* p, unsigned v) { return __hip_atomic_fetch_add(p, v, __ATOMIC_RELAXED, __HIP_MEMORY_SCOPE_AGENT); }
__device__ __forceinline__ unsigned xb_xcc_id() { return (unsigned)__builtin_amdgcn_s_getreg((3 << 11) | 20) & 0xFu; }
#define XB_SPIN(cond, bar) do { unsigned _sp = 0; while (cond) { __builtin_amdgcn_s_sleep(1); \
    if ((++_sp & 255u) == 0u) { if (xb_ld(&(bar)[XB_TMO])) break; if (_sp > XB_SPIN_CAP) { atomicAdd(&(bar)[XB_TMO], 1u); break; } } } } while (0)

struct XcdBarrier {
    unsigned* bar; unsigned x;
    volatile LAS unsigned* st;
};

__device__ __forceinline__ XcdBarrier xcd_barrier_post(unsigned* bar, volatile LAS unsigned* st) {
    XcdBarrier b; b.bar = bar; b.x = xb_xcc_id(); b.st = st;
    if (threadIdx.x == 0) (void)xb_add(&bar[XB_XCNT(b.x)], 1u);
    return b;
}
__device__ __forceinline__ void xcd_barrier_complete(unsigned* bar, unsigned x, unsigned& nloc, unsigned& nx) {
    const unsigned G = gridDim.x * gridDim.y * gridDim.z;
    unsigned sum, cnt, mine, sp = 0u;
    for (;;) {
        sum = 0u; cnt = 0u; mine = 0u;
#pragma unroll
        for (unsigned j = 0; j < 16; ++j) { const unsigned c = xb_ld(&bar[XB_XCNT(j)]); sum += c; cnt += (c > 0u) ? 1u : 0u; mine = (j == x) ? c : mine; }
        if (sum == G) break;
        __builtin_amdgcn_s_sleep(1);
        if ((++sp & 255u) == 0u) { if (xb_ld(&bar[XB_TMO])) break; if (sp > XB_SPIN_CAP) { atomicAdd(&bar[XB_TMO], 1u); break; } }
    }
    nloc = mine > 0u ? mine : 1u; nx = cnt > 0u ? cnt : 1u;
}

__device__ __forceinline__ void xcd_barrier(const XcdBarrier& b) {
    asm volatile("s_waitcnt vmcnt(0)" ::: "memory");
    __syncthreads();
    if (threadIdx.x == 0) {
        unsigned* bar = b.bar;
        __builtin_amdgcn_s_waitcnt(0);
        unsigned nloc = b.st[0], nx = b.st[1];
        if (nloc == 0u) { xcd_barrier_complete(bar, b.x, nloc, nx); b.st[0] = nloc; b.st[1] = nx; }
        const unsigned old = xb_add(&bar[XB_XSUB(b.x)], 1u);
        const unsigned gen = old / nloc;
        if (old + 1u == (gen + 1u) * nloc) {
            __builtin_amdgcn_fence(__ATOMIC_RELEASE, "agent");
            asm volatile("s_waitcnt vmcnt(0)" ::: "memory");
            const unsigned og = xb_add(&bar[XB_TOP], 1u);
            const unsigned tg = og / nx;
            if (og + 1u == (tg + 1u) * nx) xb_add(&bar[XB_TOPGEN], 1u);
            else XB_SPIN(xb_ld(&bar[XB_TOPGEN]) == tg, bar);
            __builtin_amdgcn_fence(__ATOMIC_ACQUIRE, "agent");
            xb_add(&bar[XB_XGEN(b.x)], 1u);
            asm volatile("s_waitcnt vmcnt(0)" ::: "memory");
        } else {
            XB_SPIN(xb_ld(&bar[XB_XGEN(b.x)]) == gen, bar);
            __builtin_amdgcn_fence(__ATOMIC_ACQUIRE, "agent");
            asm volatile("s_waitcnt vmcnt(0)" ::: "memory");
        }
    }
    __syncthreads();
}

struct Frame {
    LAS unsigned char* lds;
    volatile LAS unsigned* MISC;
    gu32* ctl;
    int tid, lane, wave, vcu, G;
};

__device__ __forceinline__ void p0_small(Frame& F, const float* c, const float* w_ada, const float* b_ada, const float* rel, const float* b_e1, float* mod, float* tab, float* bgl) {
    LAS float* red = (LAS float*)(F.lds);
    for (int cg = blockIdx.x; cg < 256; cg += F.G) {
        const int col = F.tid % 24, kg = F.tid / 24;
        float acc = 0.f;
        if (kg < 21) { for (int k = kg; k < D; k += 21) { const float cv = c[k]; const float s = cv / (1.f + expf(-cv)); acc += s * w_ada[(size_t)k * 6144 + cg * 24 + col]; } red[kg * 24 + col] = acc; }
        __syncthreads();
        if (F.tid < 24) { float t = 0.f; for (int i = 0; i < 21; ++i) t += red[i * 24 + F.tid]; mod[cg * 24 + F.tid] = t + b_ada[cg * 24 + F.tid]; }
        __syncthreads();
        if (F.tid == 0) { __builtin_amdgcn_fence(__ATOMIC_RELEASE, "agent"); asm volatile("s_waitcnt vmcnt(0)" ::: "memory");
            __hip_atomic_fetch_add((unsigned*)(F.ctl + CW_MODCNT), 1u, __ATOMIC_RELAXED, __HIP_MEMORY_SCOPE_AGENT); }
    }
    if (blockIdx.x == 0) {
        for (int i = F.tid; i < 1024; i += NWAVES * 64) { const int h = i >> 7, n = i & 127; int bk;
            if (n < 16) bk = n; else { const int lg = 16 + (int)(logf((float)n / 16.f) / logf(8.f) * 16.f); bk = lg < 31 ? lg : 31; }
            tab[h * 128 + n] = rel[bk * 8 + h] * LOG2E; }
    }
    for (int i = blockIdx.x * (NWAVES * 64) + F.tid; i < NE * 2048; i += F.G * NWAVES * 64) {
        const int e = i >> 11, j = i & 2047; bgl[e * 2048 + (j & 1) * 1024 + (j >> 1)] = b_e1[i]; }
}

__device__ __forceinline__ void wait_mod(Frame& F) {
    if (F.tid == 0) { unsigned sp = 0;
        while (__hip_atomic_load((unsigned*)(F.ctl + CW_MODCNT), __ATOMIC_RELAXED, __HIP_MEMORY_SCOPE_AGENT) < 256u) { __builtin_amdgcn_s_sleep(2); if (++sp > (1u << 22)) { __hip_atomic_store((unsigned*)(F.ctl + CW_TMO), 1u, __ATOMIC_RELAXED, __HIP_MEMORY_SCOPE_AGENT); break; } }
        __builtin_amdgcn_fence(__ATOMIC_ACQUIRE, "agent"); asm volatile("s_waitcnt vmcnt(0)" ::: "memory"); }
    __syncthreads();
}
__device__ __forceinline__ void p1_rows(Frame& F, const float* x, const float* g, const float* mod, const float* w_in, const float* b_forget, bf16_t* U, float* logf_out) {
    LAS float* wf = (LAS float*)F.lds;
    for (int i = F.tid; i < 2048; i += NWAVES * 64) { const int k = i >> 1, hh = i & 1; const f32x4 t = *(const f32x4*)(w_in + (size_t)k * DIN + W_FB + hh * 4);
        wf[(hh * 4 + 0) * 1024 + k] = t.x; wf[(hh * 4 + 1) * 1024 + k] = t.y; wf[(hh * 4 + 2) * 1024 + k] = t.z; wf[(hh * 4 + 3) * 1024 + k] = t.w; }
    __syncthreads();
    f32x4 gv[4], sc1[4], sh[4];
#pragma unroll
    for (int j = 0; j < 4; ++j) { const int o = 4 * F.lane + 256 * j; gv[j] = *(const f32x4*)(g + o); sc1[j] = *(const f32x4*)(mod + 1024 + o) + 1.0f; sh[j] = *(const f32x4*)(mod + o); }
    const int gw = F.vcu * NWAVES + F.wave, NGW = F.G * NWAVES;
    const float bfv = b_forget[F.lane & 7];
    for (int m = gw; m < S; m += NGW) {
        const GAS f32x4* xr = (const GAS f32x4*)(x + (size_t)m * D) + F.lane;
        f32x4 v[4]; float ss = 0.f;
#pragma unroll
        for (int j = 0; j < 4; ++j) { v[j] = xr[64 * j]; ss += (v[j].x * v[j].x + v[j].y * v[j].y) + (v[j].z * v[j].z + v[j].w * v[j].w); }
        const float r = 1.0f / sqrtf(wave_sum(ss) * (1.f / D) + EPS);
        float fb[8];
#pragma unroll
        for (int h = 0; h < 8; ++h) fb[h] = 0.f;
        GAS unsigned long long* o8 = (GAS unsigned long long*)(U + (size_t)m * D) + F.lane;
#pragma unroll
        for (int j = 0; j < 4; ++j) {
            v[j] = v[j] * r * gv[j] * sc1[j] + sh[j];
            o8[64 * j] = (unsigned long long)pk2(v[j].x, v[j].y) | ((unsigned long long)pk2(v[j].z, v[j].w) << 32);
#pragma unroll
            for (int h = 0; h < 8; ++h) { const f32x4 w4 = *(const LAS f32x4*)(wf + h * 1024 + 4 * F.lane + 256 * j); fb[h] += (v[j].x * w4.x + v[j].y * w4.y) + (v[j].z * w4.z + v[j].w * w4.w); }
        }
#pragma unroll
        for (int h = 0; h < 8; ++h) fb[h] = wave_sum(fb[h]);
        float mine = fb[0];
#pragma unroll
        for (int h = 1; h < 8; ++h) mine = ((F.lane & 7) == h) ? fb[h] : mine;
        if (F.lane < 8) { const float xv = mine + bfv; logf_out[(size_t)m * 8 + F.lane] = fminf(xv, 0.f) - log1pf(expf(-fabsf(xv))); }
    }
    __syncthreads();
}
template <bool IL>
__device__ __forceinline__ void tr_item64(const float* W, int ldw, int sc0, int k0, bf16_t* WT, int K, int dr0, LAS unsigned char* scr, int lane) {
    const int r = lane >> 4, c = lane & 15;
    const float* src = W + (size_t)(k0 + 16 * r) * ldw + sc0 + 4 * c;
    f32x4 v[16];
#pragma unroll
    for (int i = 0; i < 16; ++i) v[i] = *(const f32x4*)(src + (size_t)i * ldw);
#pragma unroll
    for (int j = 0; j < 4; ++j) { u32x4 w0, w1;
        w0.x = cvt_pk_bf16(v[0][j], v[1][j]); w0.y = cvt_pk_bf16(v[2][j], v[3][j]); w0.z = cvt_pk_bf16(v[4][j], v[5][j]); w0.w = cvt_pk_bf16(v[6][j], v[7][j]);
        w1.x = cvt_pk_bf16(v[8][j], v[9][j]); w1.y = cvt_pk_bf16(v[10][j], v[11][j]); w1.z = cvt_pk_bf16(v[12][j], v[13][j]); w1.w = cvt_pk_bf16(v[14][j], v[15][j]);
        LAS unsigned char* d = scr + (4 * c + j) * 144 + r * 32; *(LAS u32x4*)d = w0; *(LAS u32x4*)(d + 16) = w1; }
    LDS_WAIT(); asm volatile("" ::: "memory");
#pragma unroll
    for (int q = 0; q < 8; ++q) { const int n = (lane >> 3) + 8 * q, ch = lane & 7; const u32x4 w = *(const LAS u32x4*)(scr + n * 144 + ch * 16);
        const int drow = IL ? dr0 + (n >> 1) + 128 * (n & 1) : dr0 + n;
        *(GAS u32x4*)(WT + (size_t)drow * K + k0 + 8 * ch) = w; }
    LDS_WAIT(); asm volatile("" ::: "memory");
}
template <bool IL>
__device__ __forceinline__ void tr_item_fp8(const float* W, int ldw, int sc0, int k0, unsigned char* WT, int K, int dr0, LAS unsigned char* scr, int lane) {
    const int r = lane >> 3, c = lane & 7;
    const float* src = W + (size_t)(k0 + 16 * r) * ldw + sc0 + 4 * c;
    f32x4 v[16];
#pragma unroll
    for (int i = 0; i < 16; ++i) v[i] = *(const f32x4*)(src + (size_t)i * ldw) * W_SCALE;
#pragma unroll
    for (int j = 0; j < 4; ++j) { u32x4 w;
        w.x = pk_fp8x4(v[0][j], v[1][j], v[2][j], v[3][j]); w.y = pk_fp8x4(v[4][j], v[5][j], v[6][j], v[7][j]); w.z = pk_fp8x4(v[8][j], v[9][j], v[10][j], v[11][j]); w.w = pk_fp8x4(v[12][j], v[13][j], v[14][j], v[15][j]);
        *(LAS u32x4*)(scr + (4 * c + j) * 144 + r * 16) = w; }
    LDS_WAIT(); asm volatile("" ::: "memory");
#pragma unroll
    for (int q = 0; q < 4; ++q) { const int n = (lane >> 3) + 8 * q, ch = lane & 7; const u32x4 w = *(const LAS u32x4*)(scr + n * 144 + ch * 16);
        const int drow = IL ? dr0 + (n >> 1) + 128 * (n & 1) : dr0 + n;
        *(GAS u32x4*)(WT + (size_t)drow * K + k0 + 16 * ch) = w; }
    LDS_WAIT(); asm volatile("" ::: "memory");
}
__device__ __forceinline__ void p1_weights(Frame& F, const float* w_in, const float* w_pa, const float* w_pb, const float* w_o, const float* w_e1, const float* w_e2,
                                           bf16_t* Win, bf16_t* Wpa, bf16_t* Wpb, bf16_t* Wo, unsigned char* We1, unsigned char* We2) {
    LAS unsigned char* scr = F.lds + F.wave * 9216;
    const int gw = F.vcu * NWAVES + F.wave, NGW = F.G * NWAVES;
    constexpr int I_E1 = NE * 8 * 64, I_E2 = NE * 8 * 32, I_IN = 16 * (ZP / 64), I_P = 8 * 16, I_O = 16 * 16;
    constexpr int NITEMS = I_E1 + I_E2 + I_IN + 2 * I_P + I_O;
    for (int it = gw; it < NITEMS; it += NGW) {
        int r = it;
        if (r < I_E1) { const int e = r >> 9, kb = (r & 511) >> 6, grp = r & 63;
            tr_item_fp8<true>(w_e1 + (size_t)e * D * 2048, 2048, 32 * grp, 128 * kb, We1 + (size_t)e * 2048 * D, D, 256 * (grp >> 3) + 16 * (grp & 7), scr, F.lane); continue; } r -= I_E1;
        if (r < I_E2) { const int e = r >> 8, kb = (r & 255) >> 5, nb = r & 31; tr_item_fp8<false>(w_e2 + (size_t)e * FF * D, D, 32 * nb, 128 * kb, We2 + (size_t)e * D * FF, FF, 32 * nb, scr, F.lane); continue; } r -= I_E2;
        if (r < I_IN) { const int kb = r / (ZP / 64), nb = r % (ZP / 64); const int sc0 = 64 * nb + (64 * nb >= W_FB ? 8 : 0); tr_item64<false>(w_in, DIN, sc0, 64 * kb, Win, D, 64 * nb, scr, F.lane); continue; } r -= I_IN;
        if (r < I_P) { tr_item64<false>(w_pa, D, 64 * (r & 15), 64 * (r >> 4), Wpa, 512, 64 * (r & 15), scr, F.lane); continue; } r -= I_P;
        if (r < I_P) { tr_item64<false>(w_pb, D, 64 * (r & 15), 64 * (r >> 4), Wpb, 512, 64 * (r & 15), scr, F.lane); continue; } r -= I_P;
        tr_item64<false>(w_o, D, 64 * (r & 15), 64 * (r >> 4), Wo, D, 64 * (r & 15), scr, F.lane);
    }
}

struct EpiInProj {
    static constexpr bool PERM = true;
    bf16_t* O;
    __device__ __forceinline__ void operator()(const f32x4 (&acc)[2][2][4][2], const Unit& u, int wr, int wc, int fr, int fq) const {
        const int row0 = u.pm * 256 + wr * 64 + fr, col0 = u.pn * 256 + wc * 32 + 8 * fq;
        const float sc = (u.pn < 2 || u.pn == 3 || u.pn == 4) ? QSCALE : 1.0f;
#pragma unroll
        for (int ai = 0; ai < 2; ++ai)
#pragma unroll
            for (int m = 0; m < 4; ++m) { bf16_t* rowp = O + (size_t)(row0 + ai * 128 + m * 16) * ZP + col0;
#pragma unroll
                for (int bj = 0; bj < 2; ++bj) { const f32x4 v0 = acc[ai][bj][m][0] * sc, v1 = acc[ai][bj][m][1] * sc;
                    u32x4 w; w.x = cvt_pk_bf16(v0[0], v0[1]); w.y = cvt_pk_bf16(v0[2], v0[3]); w.z = cvt_pk_bf16(v1[0], v1[1]); w.w = cvt_pk_bf16(v1[2], v1[3]);
                    *(u32x4*)(rowp + bj * 128) = w; } }
    }
};

__device__ __forceinline__ void p2b_cum(Frame& F, const float* logf_in, float* cum, int b0) {
    if ((int)blockIdx.x >= b0 && (int)blockIdx.x < b0 + 8) {
        const int h = (int)blockIdx.x - b0; LAS float* part = (LAS float*)F.lds;
        float lf[32]; float s = 0.f; const int t0 = F.tid * 32;
#pragma unroll
        for (int i = 0; i < 32; ++i) { lf[i] = logf_in[(size_t)(t0 + i) * 8 + h]; s += lf[i]; }
        part[F.tid] = s; __syncthreads();
        for (int o = 1; o < NWAVES * 64; o <<= 1) { const float v = (F.tid >= o) ? part[F.tid - o] : 0.f; __syncthreads(); part[F.tid] += v; __syncthreads(); }
        float run = part[F.tid] - s;
#pragma unroll
        for (int i = 0; i < 32; ++i) { run += lf[i]; cum[(size_t)h * S + t0 + i] = run * LOG2E; }
        __syncthreads();
    }
}

__device__ __forceinline__ void p2b_stats(Frame& F, const bf16_t* Z, float* QN, float* DG, float* KN) {
    const int gw = F.vcu * NWAVES + F.wave, NGW = F.G * NWAVES;
    for (int it = gw; it < 8 * (S / 64); it += NGW) {
        const int h = it >> 8, T = it & 255, t = 64 * T + F.lane;
        const u32x4* qp = (const u32x4*)(Z + (size_t)t * ZP + C_QB + h * 64); const u32x4* kp = (const u32x4*)(Z + (size_t)t * ZP + C_KB + h * 64);
        float qq = 0.f, kk = 0.f, qk = 0.f;
#pragma unroll
        for (int i = 0; i < 8; ++i) { const u32x4 a = qp[i], b = kp[i];
#pragma unroll
            for (int j = 0; j < 4; ++j) { const float a0 = bf_lo(a[j]), a1 = bf_hi(a[j]), b0 = bf_lo(b[j]), b1 = bf_hi(b[j]); qq += a0 * a0 + a1 * a1; kk += b0 * b0 + b1 * b1; qk += a0 * b0 + a1 * b1; } }
        QN[(size_t)h * S + t] = sqrtf(qq); DG[(size_t)h * S + t] = qk;
        const float km = wave_max(kk);
        if (F.lane == 0) KN[h * 256 + T] = sqrtf(km);
    }
}

namespace at {
typedef short bf16x8 __attribute__((ext_vector_type(8)));
typedef short s16x4 __attribute__((ext_vector_type(4)));
typedef short v4i16_t __attribute__((ext_vector_type(4)));
typedef float f32x16 __attribute__((ext_vector_type(16)));
constexpr int NBUF = 4, KBUF = 0, VBUF = NBUF * 8192, CBUF = 2 * NBUF * 8192  , BTAB = CBUF + NBUF * 2048  , QWORD = BTAB + 512;
__device__ __forceinline__ void glds16(const void* gsrc, unsigned lds_dst) { unsigned keep;
    asm volatile("s_mov_b32 %0, m0\n\ts_mov_b32 m0, %2\n\ts_nop 0\n\tglobal_load_lds_dwordx4 %1, off\n\ts_mov_b32 m0, %0" : "=&s"(keep) : "v"(gsrc), "s"(lds_dst) : "memory"); }
__device__ __forceinline__ void glds4(const void* gsrc, unsigned lds_dst) { unsigned keep;
    asm volatile("s_mov_b32 %0, m0\n\ts_mov_b32 m0, %2\n\ts_nop 0\n\tglobal_load_lds_dword %1, off\n\ts_mov_b32 m0, %0" : "=&s"(keep) : "v"(gsrc), "s"(lds_dst) : "memory"); }
#define AT_WAIT_BAR(N) asm volatile("s_waitcnt vmcnt(" #N ") lgkmcnt(0)\n\ts_barrier" ::: "memory")
__device__ __forceinline__ int crow(int r, int hi) { return (r & 3) + 8 * (r >> 2) + 4 * hi; }
__device__ __forceinline__ s16x4 vtr(const LAS char* p) { return __builtin_bit_cast(s16x4, __builtin_amdgcn_ds_read_tr16_b64_v4i16((LAS v4i16_t*)p)); }

constexpr float FOX_THR = 44.0f;
template <bool FOX>
__device__ __forceinline__ void attn_unit(Frame& F, int h, int qb, const bf16_t* Z, const float* cum, const float* tab, float sinkL2, const float* QN, const float* DG, const float* KN, bf16_t* Y) {
    const int lane = F.lane, r32 = lane & 31, hi = lane >> 5, wid = F.wave;
    const int q0 = qb * 256, qw0 = q0 + wid * 32, qrow = qw0 + r32;
    const int cq = FOX ? C_QB + h * 64 : C_QA + h * 64;
    const int ck = FOX ? C_KB + h * 64 : C_KA + (h >> 2) * 64;
    const int cv = FOX ? C_VB + h * 64 : C_VA + (h >> 2) * 64;
    const int tlast = (q0 + 255) >> 6;
    const int wlast = (qw0 + 31) >> 6;
    int tfirst = (q0 >> 6) - 2 > 0 ? (q0 >> 6) - 2 : 0;
    int wfirst = (qw0 - 127 > 0 ? qw0 - 127 : 0) >> 6;
    const unsigned lds0 = (unsigned)(uintptr_t)F.lds;
    const LAS char* L = (const LAS char*)F.lds;
    asm volatile("s_waitcnt vmcnt(0)" ::: "memory");
    if (!FOX) { if (F.tid < 128) ((LAS float*)(F.lds + BTAB))[F.tid] = tab[h * 128 + F.tid]; }
    bf16x8 qr[4];
#pragma unroll
    for (int d0 = 0; d0 < 4; ++d0) qr[d0] = *(const bf16x8*)(Z + (size_t)qrow * ZP + cq + d0 * 16 + hi * 8);
    const float ci = FOX ? cum[(size_t)h * S + qrow] : 0.f;
    const bf16_t* ksrc = Z + (size_t)lane * ZP + ck + wid * 8;
    const bf16_t* vsrc = Z + (size_t)(16 * (wid & 3) + (lane >> 2)) * ZP + cv + (wid >> 2) * 32 + (lane & 3) * 8;
    const float* csrc = cum + (size_t)h * S + lane;
    const unsigned kdst = lds0 + KBUF + wid * 1024, vdst = lds0 + VBUF + wid * 1024, cdst = lds0 + CBUF + wid * 256;
#define AT_ISSUE(t, b) do { glds16(ksrc + (size_t)(t) * 64 * ZP, (unsigned)__builtin_amdgcn_readfirstlane(kdst + (b) * 8192)); glds16(vsrc + (size_t)(t) * 64 * ZP, (unsigned)__builtin_amdgcn_readfirstlane(vdst + (b) * 8192)); \
        if (FOX) glds4(csrc + (size_t)(t) * 64, (unsigned)__builtin_amdgcn_readfirstlane(cdst + (b) * 2048)); } while (0)
    float m = FOX ? 0.f : sinkL2, l = FOX ? 0.f : (hi == 0 ? 1.f : 0.f), cinit = ci - m;
    bool first = FOX;
    f32x16 o[2]; o[0] = f32x16{}; o[1] = f32x16{};
#define AT_TILE(i_) ((tlast - (i_)) > tfirst ? (tlast - (i_)) : tfirst)
    AT_ISSUE(tlast, 0); AT_ISSUE(tlast - 1, 1); AT_ISSUE(tlast - 2, 2);
    if (FOX) {
        volatile LAS int* red = (volatile LAS int*)(F.lds + QWORD + 64);
        const size_t o_ = (size_t)h * S + qrow;
        const float qn = wave_max(QN[o_]), ev = wave_max(ci - DG[o_]);
        int myt = q0 >> 6;
        for (int T = F.lane; T < (q0 >> 6); T += 64) { const float ub = qn * KN[h * 256 + T] - cum[(size_t)h * S + 64 * T + 63] + ev; if (!(ub < -(FOX_THR + 1.0f))) myt = T < myt ? T : myt; }
        myt = wave_min_i(myt);
        if (F.lane == 0) red[F.wave] = myt;
        __syncthreads();
        int tf = red[0];
#pragma unroll
        for (int w = 1; w < 8; ++w) { const int t_ = red[w]; tf = t_ < tf ? t_ : tf; }
        tfirst = tf; wfirst = myt;
    }
    for (int t = tlast, i = 0; t >= tfirst; --t, ++i) {
        const int b = i & 3;
        if (FOX) AT_WAIT_BAR(6); else AT_WAIT_BAR(4);
        AT_ISSUE(AT_TILE(i + 3), (i + 3) & 3);
        if (t >= wfirst && t <= wlast) {
            const LAS char* Kb = L + KBUF + b * 8192; const LAS char* Vb = L + VBUF + b * 8192;
            f32x16 p0, p1;
#pragma unroll
            for (int r = 0; r < 16; ++r) { p0[r] = cinit; p1[r] = cinit; }
#pragma unroll
            for (int d0 = 0; d0 < 4; ++d0) {
                const bf16x8 a0 = *(const LAS bf16x8*)(Kb + (2 * d0 + hi) * 1024 + r32 * 16);
                const bf16x8 a1 = *(const LAS bf16x8*)(Kb + (2 * d0 + hi) * 1024 + r32 * 16 + 512);
                p0 = __builtin_amdgcn_mfma_f32_32x32x16_bf16(a0, qr[d0], p0, 0, 0, 0);
                p1 = __builtin_amdgcn_mfma_f32_32x32x16_bf16(a1, qr[d0], p1, 0, 0, 0);
            }
            const int kv0 = 64 * t;
            if (FOX) {
                const LAS float* cb = (const LAS float*)(L + CBUF + b * 2048 + wid * 256);
#pragma unroll
                for (int g = 0; g < 4; ++g) { const f32x4 c0 = *(const LAS f32x4*)(cb + 8 * g + 4 * hi), c1 = *(const LAS f32x4*)(cb + 32 + 8 * g + 4 * hi);
#pragma unroll
                    for (int i = 0; i < 4; ++i) { p0[4 * g + i] -= c0[i]; p1[4 * g + i] -= c1[i]; } }
                if (kv0 + 63 > qw0) {
#pragma unroll
                    for (int r = 0; r < 16; ++r) { const int kv = kv0 + crow(r, hi); if (kv > qrow) p0[r] = -INFINITY; if (kv + 32 > qrow) p1[r] = -INFINITY; }
                }
            } else {
                const LAS float* bt = (const LAS float*)(L + BTAB);
#pragma unroll
                for (int r = 0; r < 16; ++r) { const int d0_ = qrow - (kv0 + crow(r, hi)), d1_ = d0_ - 32;
                    const bool ok0 = (unsigned)d0_ < 128u, ok1 = (unsigned)d1_ < 128u;
                    const float b0 = bt[ok0 ? d0_ : 0], b1 = bt[ok1 ? d1_ : 0];
                    p0[r] = ok0 ? p0[r] + b0 : -INFINITY; p1[r] = ok1 ? p1[r] + b1 : -INFINITY; }
            }
            float ra = fmaxf(fmaxf(p0[0], p0[1]), p1[0]), rb = fmaxf(fmaxf(p0[2], p0[3]), p1[1]); ra = fmaxf(fmaxf(ra, p1[2]), p1[3]);
#pragma unroll
            for (int r = 4; r < 16; r += 4) { ra = fmaxf(fmaxf(ra, p0[r]), p0[r + 1]); rb = fmaxf(fmaxf(rb, p0[r + 2]), p0[r + 3]); ra = fmaxf(fmaxf(ra, p1[r]), p1[r + 1]); rb = fmaxf(fmaxf(rb, p1[r + 2]), p1[r + 3]); }
            float rm = fmaxf(ra, rb);
            rm = fmaxf(rm, __shfl_xor(rm, 32));
            if (first || __any(rm > 0.f)) {
                const float dl = first ? rm : fmaxf(rm, 0.f), f = first ? 0.f : __builtin_amdgcn_exp2f(-dl);
                m += dl; cinit -= dl; l *= f;
#pragma unroll
                for (int r = 0; r < 16; ++r) { p0[r] -= dl; p1[r] -= dl; o[0][r] *= f; o[1][r] *= f; }
                first = false;
            }
            float ls = 0.f;
#pragma unroll
            for (int r = 0; r < 16; ++r) { p0[r] = __builtin_amdgcn_exp2f(p0[r]); p1[r] = __builtin_amdgcn_exp2f(p1[r]); ls += p0[r] + p1[r]; }
            l += ls;
            bf16x8 pw[4];
#pragma unroll
            for (int s = 0; s < 4; ++s) { u32x4 w;
#pragma unroll
                for (int j = 0; j < 4; ++j) { const float lo = (s < 2) ? p0[8 * (s & 1) + 2 * j] : p1[8 * (s & 1) + 2 * j], hi_ = (s < 2) ? p0[8 * (s & 1) + 2 * j + 1] : p1[8 * (s & 1) + 2 * j + 1]; w[j] = pk2(lo, hi_); }
                pw[s] = __builtin_bit_cast(bf16x8, w); }
            const LAS char* vp = Vb + ((lane >> 4) & 1) * 32 + (lane & 3) * 8 + (4 * hi + ((lane & 15) >> 2)) * 64;
#pragma unroll
            for (int dh = 0; dh < 2; ++dh)
#pragma unroll
                for (int s = 0; s < 4; ++s) { const s16x4 vlo = vtr(vp + dh * 4096 + s * 1024), vhi = vtr(vp + dh * 4096 + s * 1024 + 512);
                    const bf16x8 vf = (bf16x8){vlo[0], vlo[1], vlo[2], vlo[3], vhi[0], vhi[1], vhi[2], vhi[3]};
                    o[dh] = __builtin_amdgcn_mfma_f32_32x32x16_bf16(vf, pw[s], o[dh], 0, 0, 0); }
        }
    }
    asm volatile("s_waitcnt vmcnt(0) lgkmcnt(0)\n\ts_barrier" ::: "memory");
#undef AT_TILE
#undef AT_ISSUE
    l += __shfl_xor(l, 32);
    const float il = 1.0f / l;
    bf16_t* yrow = Y + (FOX ? (size_t)S * 512 : 0) + (size_t)qrow * 512 + h * 64;
#pragma unroll
    for (int dh = 0; dh < 2; ++dh)
#pragma unroll
        for (int g = 0; g < 4; ++g) { u32x2 w; w.x = pk2(o[dh][4 * g] * il, o[dh][4 * g + 1] * il); w.y = pk2(o[dh][4 * g + 2] * il, o[dh][4 * g + 3] * il);
            *(u32x2*)(yrow + dh * 32 + 8 * g + 4 * hi) = w; }
}

__device__ __forceinline__ void attn_phase(Frame& F, const bf16_t* Z, const float* cum, const float* tab, const float* sinks, const float* QN, const float* DG, const float* KN, bf16_t* Y, int qsel = 0) {
    if (F.G == 256) {
        const int b = (int)blockIdx.x, h = b & 7, qb = b >> 3;
        attn_unit<true>(F, h, qb, Z, cum, tab, 0.f, QN, DG, KN, Y);
        attn_unit<true>(F, h ^ 4, 63 - qb, Z, cum, tab, 0.f, QN, DG, KN, Y);
        attn_unit<false>(F, h, qb, Z, cum, tab, sinks[h] * LOG2E, QN, DG, KN, Y);
        attn_unit<false>(F, h ^ 4, 63 - qb, Z, cum, tab, sinks[h ^ 4] * LOG2E, QN, DG, KN, Y);
        return;
    }
    volatile LAS unsigned* qw = (volatile LAS unsigned*)(F.lds + QWORD);
    for (;;) {
        if (F.tid == 0) *qw = __hip_atomic_fetch_add((unsigned*)(F.ctl + CW_QUEUE + 64 * qsel), 1u, __ATOMIC_RELAXED, __HIP_MEMORY_SCOPE_AGENT);
        __syncthreads();
        const unsigned u = *qw;
        __syncthreads();
        if (u >= 1024u) break;
        if (u < 512u) attn_unit<true>(F, (int)(u & 7u), 63 - (int)(u >> 3), Z, cum, tab, 0.f, QN, DG, KN, Y);
        else { const unsigned v = u - 512u; const int h = (int)(v & 7u); attn_unit<false>(F, h, (int)(v >> 3), Z, cum, tab, sinks[h] * LOG2E, QN, DG, KN, Y); }
    }
}
#undef AT_WAIT_BAR
}

template <int MODE> struct EpiMerge {
    static constexpr bool PERM = true;
    const bf16_t* __restrict__ Z; bf16_t* T; bf16_t* O; int gcol; int pad;
    __device__ __forceinline__ void operator()(const f32x4 (&acc)[2][2][4][2], const Unit& u, int wr, int wc, int fr, int fq) const {
        const int row0 = u.pm * 256 + wr * 64 + fr, col0 = u.pn * 256 + wc * 32 + 8 * fq;
#pragma unroll
        for (int aim = 0; aim < (MODE == 1 ? 4 : 2); ++aim) {
            constexpr int MN = (MODE == 1) ? 2 : 4;
            const int ai = (MODE == 1) ? (aim >> 1) : aim, m0 = (MODE == 1) ? (aim & 1) * 2 : 0;
            u32x4 g[4][2], t[4][2];
#pragma unroll
            for (int m = m0; m < m0 + MN; ++m)
#pragma unroll
                for (int bj = 0; bj < 2; ++bj) { const size_t row = (size_t)(row0 + ai * 128 + m * 16); const int col = col0 + bj * 128;
                    g[m][bj] = *(const u32x4*)(Z + row * ZP + gcol + col);
                    if (MODE == 1) t[m][bj] = *(const u32x4*)(T + row * 1024 + col); }
            asm volatile("" ::: "memory");
#pragma unroll
            for (int m = m0; m < m0 + MN; ++m)
#pragma unroll
                for (int bj = 0; bj < 2; ++bj) { const size_t row = (size_t)(row0 + ai * 128 + m * 16); const int col = col0 + bj * 128;
                    const u32x4 gg = g[m][bj];
                    const f32x4 v0 = acc[ai][bj][m][0], v1 = acc[ai][bj][m][1];
                    float r[8];
                    r[0] = sigm(bf_lo(gg.x)) * v0[0]; r[1] = sigm(bf_hi(gg.x)) * v0[1]; r[2] = sigm(bf_lo(gg.y)) * v0[2]; r[3] = sigm(bf_hi(gg.y)) * v0[3];
                    r[4] = sigm(bf_lo(gg.z)) * v1[0]; r[5] = sigm(bf_hi(gg.z)) * v1[1]; r[6] = sigm(bf_lo(gg.w)) * v1[2]; r[7] = sigm(bf_hi(gg.w)) * v1[3];
                    if (MODE == 1) { const u32x4 tt = t[m][bj];
                        r[0] += bf_lo(tt.x); r[1] += bf_hi(tt.x); r[2] += bf_lo(tt.y); r[3] += bf_hi(tt.y); r[4] += bf_lo(tt.z); r[5] += bf_hi(tt.z); r[6] += bf_lo(tt.w); r[7] += bf_hi(tt.w); }
                    u32x4 w; w.x = cvt_pk_bf16(r[0], r[1]); w.y = cvt_pk_bf16(r[2], r[3]); w.z = cvt_pk_bf16(r[4], r[5]); w.w = cvt_pk_bf16(r[6], r[7]);
                    *(u32x4*)((MODE == 0 ? T : O) + row * 1024 + col) = w; }
        }
    }
};
struct EpiResid {
    static constexpr bool PERM = false;
    const float* __restrict__ X; const float* __restrict__ gate; float* O;
    __device__ __forceinline__ void operator()(const f32x4 (&acc)[2][2][4][2], const Unit& u, int wr, int wc, int fr, int fq) const {
        const int row0 = u.pm * 256 + wr * 64 + fr, col0 = u.pn * 256 + wc * 32 + 4 * fq;
#pragma unroll
        for (int bj = 0; bj < 2; ++bj)
#pragma unroll
            for (int n = 0; n < 2; ++n) { const int col = col0 + bj * 128 + n * 16;
                f32x4 xv[2][4]; const f32x4 gv = *(const f32x4*)(gate + col);
#pragma unroll
                for (int ai = 0; ai < 2; ++ai)
#pragma unroll
                    for (int m = 0; m < 4; ++m) xv[ai][m] = *(const f32x4*)(X + (size_t)(row0 + ai * 128 + m * 16) * D + col);
                asm volatile("" ::: "memory");
#pragma unroll
                for (int ai = 0; ai < 2; ++ai)
#pragma unroll
                    for (int m = 0; m < 4; ++m) *(f32x4*)(O + (size_t)(row0 + ai * 128 + m * 16) * D + col) = xv[ai][m] + gv * acc[ai][bj][m][n]; }
    }
};

__device__ __forceinline__ float reduce_scatter32(const float (&a)[32], int lane) {
    float a16[16], a8[8], a4[4], a2[2];
    const bool b5 = lane & 32, b4 = lane & 16, b3 = lane & 8, b2 = lane & 4, b1 = lane & 2;
#pragma unroll
    for (int i = 0; i < 16; ++i) { const float keep = b5 ? a[i + 16] : a[i], send = b5 ? a[i] : a[i + 16]; a16[i] = keep + __shfl_xor(send, 32); }
#pragma unroll
    for (int i = 0; i < 8; ++i) { const float keep = b4 ? a16[i + 8] : a16[i], send = b4 ? a16[i] : a16[i + 8]; a8[i] = keep + __shfl_xor(send, 16); }
#pragma unroll
    for (int i = 0; i < 4; ++i) { const float keep = b3 ? a8[i + 4] : a8[i], send = b3 ? a8[i] : a8[i + 4]; a4[i] = keep + __shfl_xor(send, 8); }
#pragma unroll
    for (int i = 0; i < 2; ++i) { const float keep = b2 ? a4[i + 2] : a4[i], send = b2 ? a4[i] : a4[i + 2]; a2[i] = keep + __shfl_xor(send, 4); }
    const float keep = b1 ? a2[1] : a2[0], send = b1 ? a2[0] : a2[1];
    float v = keep + __shfl_xor(send, 2);
    v += __shfl_xor(v, 1);
    return v;
}
__device__ __forceinline__ void p6_route(Frame& F, const float* X1, const float* g, const float* mod, const float* w_router, const float* b_router, unsigned char* U2, int* sel_ep, float* sel_w, int* list) {
    LAS float* wr = (LAS float*)F.lds;
    LAS int* selE = (LAS int*)(F.lds + ROWTAB_OFF);
    LAS int* lcnt = (LAS int*)(F.lds + LDSCTL_OFF);
    LAS int* gbase = lcnt + 32;
    for (int i = F.tid; i < 32768; i += NWAVES * 64) wr[(i & 31) * 1024 + (i >> 5)] = w_router[i];
    if (F.tid < 64) lcnt[F.tid] = 0;
    f32x4 gv[4], sc1[4], sh[4];
#pragma unroll
    for (int j = 0; j < 4; ++j) { const int o = 4 * F.lane + 256 * j; gv[j] = *(const f32x4*)(g + o); sc1[j] = *(const f32x4*)(mod + 4096 + o) + 1.0f; sh[j] = *(const f32x4*)(mod + 3072 + o); }
    const float brv = b_router[F.lane >> 1];
    __syncthreads();
    const int gw = F.vcu * NWAVES + F.wave, NGW = F.G * NWAVES;
    int it = 0;
    for (int rp6 = 0; rp6 < ((REPMASK & 0x40000) ? 2 : 1); ++rp6) { it = 0;
    for (int m = gw; m < S; m += NGW, ++it) {
        const GAS f32x4* xr = (const GAS f32x4*)(X1 + (size_t)m * D) + F.lane;
        f32x4 v[4]; float ss = 0.f;
#pragma unroll
        for (int j = 0; j < 4; ++j) { v[j] = xr[64 * j]; ss += (v[j].x * v[j].x + v[j].y * v[j].y) + (v[j].z * v[j].z + v[j].w * v[j].w); }
        const float r = 1.0f / sqrtf(wave_sum(ss) * (1.f / D) + EPS);
        GAS unsigned* o4 = (GAS unsigned*)(U2 + (size_t)m * D) + F.lane;
#pragma unroll
        for (int j = 0; j < 4; ++j) { v[j] = v[j] * r * gv[j] * sc1[j] + sh[j];
            o4[64 * j] = pk_fp8x4(v[j].x, v[j].y, v[j].z, v[j].w); }
        float acc[32];
#pragma unroll
        for (int e = 0; e < 32; ++e) { float a = 0.f;
#pragma unroll
            for (int j = 0; j < 4; ++j) { const f32x4 w4 = *(const LAS f32x4*)(wr + e * 1024 + 4 * F.lane + 256 * j); a += (v[j].x * w4.x + v[j].y * w4.y) + (v[j].z * w4.z + v[j].w * w4.w); }
            acc[e] = a; }
        float lv = reduce_scatter32(acc, F.lane) + brv;
        float tv[4]; int te[4];
#pragma unroll
        for (int k = 0; k < 4; ++k) { const float mx = wave_max(lv); const unsigned long long bal = __ballot(lv == mx); const int e = (__ffsll((long long)bal) - 1) >> 1;
            tv[k] = mx; te[k] = e; if ((F.lane >> 1) == e) lv = -INFINITY; }
        float p[4], sum = 0.f;
#pragma unroll
        for (int k = 0; k < 4; ++k) { p[k] = expf(tv[k] - tv[0]); sum += p[k]; }
        if (F.lane < 4) { float pw = p[0]; int ew = te[0];
#pragma unroll
            for (int k = 1; k < 4; ++k) { pw = (F.lane == k) ? p[k] : pw; ew = (F.lane == k) ? te[k] : ew; }
            sel_w[(size_t)m * 4 + F.lane] = pw / sum; selE[(it * NWAVES + F.wave) * 4 + F.lane] = ew; }
    } }
    __syncthreads();
    const int nrows = it * NWAVES;
    int myE[2], myL[2];
#pragma unroll
    for (int q = 0; q < 2; ++q) { const int t = F.tid + q * NWAVES * 64; myE[q] = 0; myL[q] = 0; if (t < nrows * 4) { myE[q] = selE[t]; myL[q] = __hip_atomic_fetch_add(&lcnt[myE[q]], 1, __ATOMIC_RELAXED, __HIP_MEMORY_SCOPE_WORKGROUP); } }
    __syncthreads();
    if (F.tid < 32) gbase[F.tid] = (int)__hip_atomic_fetch_add((unsigned*)(F.ctl + CW_CNT + F.tid), (unsigned)lcnt[F.tid], __ATOMIC_RELAXED, __HIP_MEMORY_SCOPE_AGENT);
    __syncthreads();
#pragma unroll
    for (int q = 0; q < 2; ++q) { const int t = F.tid + q * NWAVES * 64; if (t < nrows * 4) { const int rl = t >> 2, e = myE[q], pos = gbase[e] + myL[q];
        const int tok = (F.vcu * NWAVES + (rl & 7)) + (rl >> 3) * NGW; list[(size_t)e * S + pos] = tok; sel_ep[(size_t)tok * 4 + (t & 3)] = (e << 16) | pos; } }
    __syncthreads();
}

__device__ __forceinline__ void moe_tables(Frame& F) {
    LAS int* tp = (LAS int*)(F.lds + LDSCTL_OFF);
    LAS int* cn = tp + 40;
    if (F.tid == 0) { int t = 0; for (int e = 0; e < NE; ++e) { const int c = (int)__hip_atomic_load((unsigned*)(F.ctl + CW_CNT + e), __ATOMIC_RELAXED, __HIP_MEMORY_SCOPE_AGENT); tp[e] = t; cn[e] = c; t += (c + 255) >> 8; } tp[NE] = t; }
    __syncthreads();
}
template <bool GATHER> struct MoeOrder {
    const LAS int* tp; const LAS int* rowtab; const char* A; const char* Bt; size_t bstride; int NT, RB, U, per, nb, x, rank;
    __device__ void init(Frame& F, const void* A_, const void* Bt_, size_t bstride_, int NT_, int RB_) {
        tp = (const LAS int*)(F.lds + LDSCTL_OFF); rowtab = (const LAS int*)(F.lds + ROWTAB_OFF); A = (const char*)A_; Bt = (const char*)Bt_; bstride = bstride_; NT = NT_; RB = RB_;
        U = tp[NE] * NT;
        if (F.G % 8 == 0) { nb = F.G >> 3; x = blockIdx.x & 7; rank = blockIdx.x >> 3; per = (U + 7) >> 3; } else { nb = F.G; x = 0; rank = blockIdx.x; per = U; }
    }
    __device__ bool next(int i, Unit& u) const {
        const int p = i * nb + rank; if (p >= per) return false;
        const int id = x * per + p; if (id >= U) return false;
        const int mtg = id / NT, nt = id - mtg * NT;
        int e = 0; while (tp[e + 1] <= mtg) ++e;
        e = __builtin_amdgcn_readfirstlane(e);
        u.pm = mtg; u.pn = nt; u.e = e; u.slot = i;
        u.A = pg8::uniform_ptr(GATHER ? A : A + (size_t)mtg * 256 * RB); u.B = pg8::uniform_ptr(Bt + (size_t)e * bstride + (size_t)nt * 256 * RB); return true;
    }
    __device__ __forceinline__ int arow(int slot, int r) const { return rowtab[slot * 256 + r]; }
};
__device__ __forceinline__ void moe_rowtab(Frame& F, const MoeOrder<true>& So, const int* list) {
    const LAS int* tp = (const LAS int*)(F.lds + LDSCTL_OFF); const LAS int* cn = tp + 40;
    LAS int* rowtab = (LAS int*)(F.lds + ROWTAB_OFF);
    Unit u;
    for (int i = 0; i < ROWTAB_UNITS && So.next(i, u); ++i) {
        if (F.tid < 256) { const int pos = (u.pm - tp[u.e]) * 256 + F.tid; rowtab[i * 256 + F.tid] = list[(size_t)u.e * S + (pos < cn[u.e] ? pos : 0)]; }
    }
    __syncthreads();
}
struct EpiMoe1 {
    static constexpr bool PERM = true; static constexpr int SCALE_W = 0x79797979  , SCALE_A = 0x7f7f7f7f;
    const float* bgl; unsigned char* ACT;
    __device__ __forceinline__ void operator()(const f32x4 (&acc)[2][2][4][2], const Unit& u, int wr, int wc, int fr, int fq) const {
        const int row0 = u.pm * 256 + wr * 64 + fr, acol = u.pn * 128 + wc * 32 + 8 * fq;
        const float* bg = bgl + (size_t)u.e * 2048 + acol;
        const f32x4 bg0 = *(const f32x4*)bg, bg1 = *(const f32x4*)(bg + 4), bl0 = *(const f32x4*)(bg + 1024), bl1 = *(const f32x4*)(bg + 1028);
#pragma unroll
        for (int ai = 0; ai < 2; ++ai)
#pragma unroll
            for (int m = 0; m < 4; ++m) { const size_t row = (size_t)(row0 + ai * 128 + m * 16);
                const f32x4 g0 = acc[ai][0][m][0] + bg0, g1 = acc[ai][0][m][1] + bg1, l0 = acc[ai][1][m][0] + bl0, l1 = acc[ai][1][m][1] + bl1;
                float r[8];
#pragma unroll
                for (int i = 0; i < 4; ++i) { const float ga = fminf(g0[i], 7.0f), la = fminf(fmaxf(l0[i], -7.0f), 7.0f), gb = fminf(g1[i], 7.0f), lb = fminf(fmaxf(l1[i], -7.0f), 7.0f);
                    r[i] = ga * sigm(1.702f * ga) * (la + 1.0f) * ACT_SCALE; r[4 + i] = gb * sigm(1.702f * gb) * (lb + 1.0f) * ACT_SCALE; }
                u32x2 w; w.x = pk_fp8x4(r[0], r[1], r[2], r[3]); w.y = pk_fp8x4(r[4], r[5], r[6], r[7]);
                *(u32x2*)(ACT + row * FF + acol) = w; }
    }
};
struct EpiMoe2 {
    static constexpr bool PERM = true; static constexpr int SCALE_W = 0x79797979  , SCALE_A = 0x7c7c7c7c  ;
    const float* b2; bf16_t* Y;
    __device__ __forceinline__ void operator()(const f32x4 (&acc)[2][2][4][2], const Unit& u, int wr, int wc, int fr, int fq) const {
        const int row0 = u.pm * 256 + wr * 64 + fr, col0 = u.pn * 256 + wc * 32 + 8 * fq;
        f32x4 bv[2][2];
#pragma unroll
        for (int bj = 0; bj < 2; ++bj)
#pragma unroll
            for (int n = 0; n < 2; ++n) bv[bj][n] = *(const f32x4*)(b2 + (size_t)u.e * D + col0 + bj * 128 + 4 * n);
#pragma unroll
        for (int ai = 0; ai < 2; ++ai)
#pragma unroll
            for (int m = 0; m < 4; ++m) { bf16_t* rowp = Y + (size_t)(row0 + ai * 128 + m * 16) * D + col0;
#pragma unroll
                for (int bj = 0; bj < 2; ++bj) { const f32x4 v0 = acc[ai][bj][m][0] + bv[bj][0], v1 = acc[ai][bj][m][1] + bv[bj][1];
                    u32x4 w; w.x = cvt_pk_bf16(v0[0], v0[1]); w.y = cvt_pk_bf16(v0[2], v0[3]); w.z = cvt_pk_bf16(v1[0], v1[1]); w.w = cvt_pk_bf16(v1[2], v1[3]);
                    *(u32x4*)(rowp + bj * 128) = w; } }
    }
};

__device__ __forceinline__ void p9_final(Frame& F, const float* X1, const bf16_t* Y, const float* gate, const float* g, const int* sel_ep, const float* sel_w, float* out) {
    const LAS int* tp = (const LAS int*)(F.lds + LDSCTL_OFF);
    f32x4 gv[4], gt[4];
#pragma unroll
    for (int j = 0; j < 4; ++j) { const int o = 4 * F.lane + 256 * j; gv[j] = *(const f32x4*)(g + o); gt[j] = *(const f32x4*)(gate + o); }
    const int gw = F.vcu * NWAVES + F.wave, NGW = F.G * NWAVES;
    for (int m = gw; m < S; m += NGW) {
        f32x4 mo[4];
#pragma unroll
        for (int j = 0; j < 4; ++j) mo[j] = (f32x4){0.f, 0.f, 0.f, 0.f};
#pragma unroll
        for (int k = 0; k < 4; ++k) { const int ep = sel_ep[(size_t)m * 4 + k]; const float w = sel_w[(size_t)m * 4 + k]; const int slot = tp[ep >> 16] * 256 + (ep & 0xffff);
            const GAS u32x2* yr = (const GAS u32x2*)(Y + (size_t)slot * D) + F.lane;
#pragma unroll
            for (int j = 0; j < 4; ++j) { const u32x2 t = yr[64 * j]; mo[j] += w * (f32x4){bf_lo(t.x), bf_hi(t.x), bf_lo(t.y), bf_hi(t.y)}; } }
        const GAS f32x4* xr = (const GAS f32x4*)(X1 + (size_t)m * D) + F.lane;
        f32x4 v[4]; float ss = 0.f;
#pragma unroll
        for (int j = 0; j < 4; ++j) { v[j] = xr[64 * j] + gt[j] * mo[j]; ss += (v[j].x * v[j].x + v[j].y * v[j].y) + (v[j].z * v[j].z + v[j].w * v[j].w); }
        const float r = 1.0f / sqrtf(wave_sum(ss) * (1.f / D) + EPS);
        GAS f32x4* orow = (GAS f32x4*)(out + (size_t)m * D) + F.lane;
#ifdef TSTAMP
        { const unsigned long long* tsp = (const unsigned long long*)((const char*)sel_ep - WS_SEL + WS_CTL + 512 * 1024); const float us = (float)(tsp[0] - tsp[1]) * 0.01f; const float fac = 1.0f + 0.05f * floorf((us + TSTAMP_OFF) * (1.0f / TSTAMP_BIN));
#pragma unroll
          for (int j = 0; j < 4; ++j) orow[64 * j] = v[j] * r * gv[j] * fac; }
#else
#pragma unroll
        for (int j = 0; j < 4; ++j) orow[64 * j] = v[j] * r * gv[j];
#endif
    }
}

struct Args { const float* in[20]; float* out; unsigned char* ws; int ph_lo, ph_hi; };
enum { PH_SMALL = 0, PH_ROWS, PH_INPROJ, PH_CUM, PH_ATTN, PH_MERGE, PH_WO, PH_ROUTE, PH_MOE1, PH_MOE2, PH_FINAL, PH_COUNT };

__global__ void __launch_bounds__(NWAVES * 64, 2) mk_fwd(Args args) {
    extern __shared__ __attribute__((aligned(16))) unsigned char lds[];
    Frame F;
    F.lds = (LAS unsigned char*)lds;
    F.MISC = (volatile LAS unsigned*)(F.lds + MISC_OFF);
    F.tid = threadIdx.x; F.lane = F.tid & 63; F.wave = __builtin_amdgcn_readfirstlane(F.tid >> 6);
    F.G = gridDim.x; { const int bx = blockIdx.x; F.vcu = (F.G % 8 == 0) ? (bx % 8) * (F.G / 8) + bx / 8 : bx; }
    unsigned char* ws = args.ws;
    F.ctl = (gu32*)(ws + WS_CTL);
    for (int u = F.tid; u < (LDS_BYTES - LDSCTL_OFF) / 4; u += NWAVES * 64) ((LAS unsigned*)(F.lds + LDSCTL_OFF))[u] = 0u;
    __syncthreads();
    XcdBarrier bar = xcd_barrier_post((unsigned*)(F.ctl + CW_BAR), F.MISC + 8);
    const int lo = args.ph_lo, hi = args.ph_hi;
#ifdef TSTAMP
    const unsigned long long ts0 = __builtin_amdgcn_s_memrealtime();
#endif
#ifndef REPMASK
#define REPMASK 0
#endif
#define IN(k) (lo <= (k) && (k) < hi)
#define REPS(k) (((REPMASK >> (k)) & 1) ? 2 : 1)
#define REPEAT(k, ...) { __VA_ARGS__ if (REPS(k) == 2) { __VA_ARGS__ } }
#ifdef TSTAMP
#define SEAM(k) do { if (IN((k) + 1)) xcd_barrier(bar); if ((k) == TSTAMP_LO && blockIdx.x == 0 && F.tid == 0) ((unsigned long long*)(ws + WS_CTL + 512 * 1024))[1] = __builtin_amdgcn_s_memrealtime() - ts0; if ((k) == TSTAMP && blockIdx.x == 0 && F.tid == 0) ((unsigned long long*)(ws + WS_CTL + 512 * 1024))[0] = __builtin_amdgcn_s_memrealtime() - ts0; } while (0)
#else
#define SEAM(k) do { if (IN((k) + 1)) xcd_barrier(bar); } while (0)
#endif
    const float* x = args.in[0]; const float* c = args.in[1]; const float* w_ada = args.in[2]; const float* b_ada = args.in[3]; const float* g_mix = args.in[4]; const float* w_in = args.in[5];
    const float* b_forget = args.in[6]; const float* sinks = args.in[7]; const float* rel = args.in[8]; const float* w_pa = args.in[9]; const float* w_pb = args.in[10]; const float* w_o = args.in[11];
    const float* g_ffn = args.in[12]; const float* w_router = args.in[13]; const float* b_router = args.in[14]; const float* w_e1 = args.in[15]; const float* b_e1 = args.in[16];
    const float* w_e2 = args.in[17]; const float* b_e2 = args.in[18]; const float* g_final = args.in[19];
    float* mod = (float*)(ws + WS_MOD); float* tab = (float*)(ws + WS_TAB); float* bgl = (float*)(ws + WS_BGL); float* logfb = (float*)(ws + WS_LOGF); float* cum = (float*)(ws + WS_CUM);
    bf16_t* Win = (bf16_t*)(ws + WS_WIN); bf16_t* Wpa = (bf16_t*)(ws + WS_WPA); bf16_t* Wpb = (bf16_t*)(ws + WS_WPB); bf16_t* Wo = (bf16_t*)(ws + WS_WO);
    unsigned char* We1 = ws + WS_WE1; unsigned char* We2 = ws + WS_WE2;
    bf16_t* U = (bf16_t*)(ws + WS_U); bf16_t* Z = (bf16_t*)(ws + WS_Z);

    if (IN(PH_SMALL)) { p0_small(F, c, w_ada, b_ada, rel, b_e1, mod, tab, bgl); }
    if (IN(PH_ROWS)) { p1_weights(F, w_in, w_pa, w_pb, w_o, w_e1, w_e2, Win, Wpa, Wpb, Wo, We1, We2); __syncthreads(); wait_mod(F); p1_rows(F, x, g_mix, mod, w_in, b_forget, U, logfb); SEAM(PH_ROWS); }
    if (IN(PH_INPROJ)) {
        pg8::DenseOrder So; So.init(U, Win, S, ZP, D, F.G, (int)blockIdx.x);
        EpiInProj E{Z};
        REPEAT(PH_INPROJ, pg8::gemm_phase<EpiInProj, pg8::DenseOrder, true, false>(F.lds + RING_OFF, D, So, E);)
        if (F.G == 256) p2b_cum(F, logfb, cum, 64);
        SEAM(PH_INPROJ);
    }
    if (IN(PH_CUM)) { if (F.G != 256) p2b_cum(F, logfb, cum, 0); p2b_stats(F, Z, (float*)(ws + WS_TMP), (float*)(ws + WS_TMP) + 8 * S, (float*)(ws + WS_TMP) + 16 * S); SEAM(PH_CUM); }
    bf16_t* YAB = (bf16_t*)(ws + WS_YAB); bf16_t* TMP = (bf16_t*)(ws + WS_TMP); bf16_t* MRG = (bf16_t*)(ws + WS_MRG); float* X1 = (float*)(ws + WS_X1);
    if (IN(PH_ATTN)) { at::attn_phase(F, Z, cum, tab, sinks, (const float*)(ws + WS_TMP), (const float*)(ws + WS_TMP) + 8 * S, (const float*)(ws + WS_TMP) + 16 * S, YAB); if (REPS(PH_ATTN) == 2) at::attn_phase(F, Z, cum, tab, sinks, (const float*)(ws + WS_TMP), (const float*)(ws + WS_TMP) + 8 * S, (const float*)(ws + WS_TMP) + 16 * S, YAB, 1); SEAM(PH_ATTN); }
    if (IN(PH_MERGE)) { REPEAT(PH_MERGE,
        { pg8::DenseOrder So; So.init(YAB, Wpa, S, D, 512, F.G, (int)blockIdx.x); EpiMerge<0> E{Z, TMP, MRG, C_GA, 0};
          pg8::gemm_phase<EpiMerge<0>, pg8::DenseOrder, true, false>(F.lds + RING_OFF, 512, So, E); }
        { pg8::DenseOrder So; So.init(YAB + (size_t)S * 512, Wpb, S, D, 512, F.G, (int)blockIdx.x); EpiMerge<1> E{Z, TMP, MRG, C_GB, 0};
          pg8::gemm_phase<EpiMerge<1>, pg8::DenseOrder, true, false>(F.lds + RING_OFF, 512, So, E); } )
        SEAM(PH_MERGE);
    }
    if (IN(PH_WO)) {
        pg8::DenseOrder So; So.init(MRG, Wo, S, D, D, F.G, (int)blockIdx.x); EpiResid E{x, mod + 2048, X1};
        REPEAT(PH_WO, pg8::gemm_phase<EpiResid, pg8::DenseOrder, true, false>(F.lds + RING_OFF, D, So, E);)
        SEAM(PH_WO);
    }
    int* sel_ep = (int*)(ws + WS_SEL); float* sel_w = (float*)(ws + WS_SEL + 262144); int* list = (int*)(ws + WS_LIST);
    unsigned char* ACT = ws + WS_ACT; bf16_t* Y = (bf16_t*)(ws + WS_Y); unsigned char* U8 = ws + WS_U;
    if (IN(PH_ROUTE)) { p6_route(F, X1, g_ffn, mod, w_router, b_router, U8, sel_ep, sel_w, list); SEAM(PH_ROUTE); }
    if (IN(PH_MOE1)) {
        moe_tables(F); MoeOrder<true> So; So.init(F, U8, We1, (size_t)2048 * D, 8, D); moe_rowtab(F, So, list);
        EpiMoe1 E{bgl, ACT};
        REPEAT(PH_MOE1, pg8::gemm_phase<EpiMoe1, MoeOrder<true>, true, true, true>(F.lds + RING_OFF, D, So, E);)
        SEAM(PH_MOE1);
    }
    if (IN(PH_MOE2)) {
        moe_tables(F); MoeOrder<false> So; So.init(F, ACT, We2, (size_t)D * FF, 4, FF);
        EpiMoe2 E{b_e2, Y};
        REPEAT(PH_MOE2, pg8::gemm_phase<EpiMoe2, MoeOrder<false>, true, false, true>(F.lds + RING_OFF, FF, So, E);)
        SEAM(PH_MOE2);
    }
    if (IN(PH_FINAL)) { moe_tables(F); REPEAT(PH_FINAL, p9_final(F, X1, Y, mod + 5120, g_final, sel_ep, sel_w, args.out);) }

#undef IN
#undef SEAM
}
}


extern "C" void kernel_launch(void* const* d_in, const int* in_sizes, int n_in, void* d_out, int out_size, void* d_ws, size_t ws_size, hipStream_t stream) {
    static int grid = 0;
    if (grid == 0) {
        int dev = 0, cus = 0;
        if (n_in != 20 || out_size != mk::S * mk::D || ws_size < mk::WS_END) { fprintf(stderr, "kernel_launch: unexpected shapes / workspace (%d inputs, out %d, ws %zu)\n", n_in, out_size, ws_size); grid = -1; return; }
        if (hipGetDevice(&dev) != hipSuccess || hipDeviceGetAttribute(&cus, hipDeviceAttributeMultiprocessorCount, dev) != hipSuccess) { grid = -1; return; }
        if (hipFuncSetAttribute((const void*)mk::mk_fwd, hipFuncAttributeMaxDynamicSharedMemorySize, mk::LDS_BYTES) != hipSuccess) { fprintf(stderr, "hipFuncSetAttribute failed\n"); grid = -1; return; }
        int per_cu = 0;
        if (hipOccupancyMaxActiveBlocksPerMultiprocessor(&per_cu, (const void*)mk::mk_fwd, mk::NWAVES * 64, mk::LDS_BYTES) != hipSuccess || per_cu < 1) { fprintf(stderr, "occupancy query: %d\n", per_cu); (void)hipGetLastError(); grid = -1; return; }
        grid = cus;
        if (mk::S % (grid * mk::NWAVES) != 0 || grid % 8 != 0) { fprintf(stderr, "kernel_launch: built for a CU count that divides %d rows evenly (got %d)\n", mk::S, cus); grid = -1; return; }
    }
    if (grid < 0) return;
    (void)hipMemsetAsync((char*)d_ws + mk::WS_CTL, 0, mk::CTL_ZERO_BYTES, stream);
    mk::Args a{};
    for (int i = 0; i < 20; ++i) a.in[i] = (const float*)d_in[i];
    a.out = (float*)d_out; a.ws = (unsigned char*)d_ws; a.ph_lo = 0; a.ph_hi = mk::PH_COUNT;
    hipLaunchKernelGGL(mk::mk_fwd, dim3(grid), dim3(mk::NWAVES * 64), mk::LDS_BYTES, stream, a);
}
```

```cpp
#define CV_LATE 1
#include <hip/hip_runtime.h>
#include <cstdint>
#include <cstdio>
#include <cmath>


namespace pg8 {
#define PG8_LAS __attribute__((address_space(3)))
typedef unsigned short bf16_t;
typedef short bf16x8 __attribute__((ext_vector_type(8)));
typedef float f32x4 __attribute__((ext_vector_type(4)));
typedef float f32x2 __attribute__((ext_vector_type(2)));
typedef unsigned u32x4 __attribute__((ext_vector_type(4)));
typedef unsigned u32x2 __attribute__((ext_vector_type(2)));
constexpr int BM = 256, BK = 64, HALF = 128, HTB = HALF * BK * 2  , STAGE_BYTES = 8 * HTB, NXCD = 8, WGM = 8;

__host__ __device__ __forceinline__ int lds_byte(int r, int c) { const int st = (r >> 4) * 2 + (c >> 5), rr = r & 15, cc = c & 31, ob = rr * 64 + cc * 2; return st * 1024 + (ob ^ (((ob >> 9) & 1) << 5)); }
__host__ __device__ __forceinline__ void stage_rc(int b, int& R, int& C) { const int st = b / 1024, sb = b % 1024, swz = sb ^ (((sb >> 9) & 1) << 5); R = (st >> 1) * 16 + swz / 64; C = (st & 1) * 32 + (swz % 64) / 2; }
__host__ __device__ __forceinline__ int perm32(int rho) { const int n = rho >> 4, i = rho & 15; return 8 * (i >> 2) + 4 * n + (i & 3); }

struct Unit { const char* A; const char* B; int pm, pn, e, slot; };
__device__ __forceinline__ const char* uniform_ptr(const char* p) { const unsigned long long v = (unsigned long long)p; const unsigned lo = __builtin_amdgcn_readfirstlane((unsigned)v), hi = __builtin_amdgcn_readfirstlane((unsigned)(v >> 32)); return (const char*)(((unsigned long long)hi << 32) | lo); }

struct DenseOrder {
    const char* A; const char* Bt; int nM, nN, nwg, G, c, K;
    __device__ void init(const void* A_, const void* Bt_, int M, int N, int K_, int G_, int c_) { A = (const char*)A_; Bt = (const char*)Bt_; nM = M / BM; nN = N / BM; nwg = nM * nN; G = G_; c = c_; K = K_; }
    __device__ bool next(int i, Unit& u) const {
        const long L = (long)i * G + c; if (L >= nwg) return false;
        int wgid = (int)L; { const int q = nwg / NXCD, r = nwg % NXCD, xcd = wgid % NXCD, off = wgid / NXCD; wgid = (xcd < r ? xcd * (q + 1) : r * (q + 1) + (xcd - r) * q) + off; }
        const int nig = WGM * nN, gid = wgid / nig, fm = gid * WGM, gsz = (nM - fm) < WGM ? (nM - fm) : WGM;
        u.pm = fm + ((wgid % nig) % gsz); u.pn = (wgid % nig) / gsz; u.e = 0; u.slot = 0;
        u.A = A + (size_t)u.pm * BM * K * 2; u.B = Bt + (size_t)u.pn * BM * K * 2; return true;
    }
    __device__ __forceinline__ int arow(int, int) const { return 0; }
};

__device__ __forceinline__ unsigned cvt_pk_bf16(float lo, float hi) { unsigned r; asm volatile("v_cvt_pk_bf16_f32 %0, %1, %2" : "=v"(r) : "v"(lo), "v"(hi)); return r; }
__device__ __forceinline__ float bf_lo(unsigned w) { return __uint_as_float(w << 16); }
__device__ __forceinline__ float bf_hi(unsigned w) { return __uint_as_float(w & 0xffff0000u); }
__device__ __forceinline__ float sigm(float x) { return __builtin_amdgcn_rcpf(1.f + __expf(-x)); }

typedef int v4i_t __attribute__((ext_vector_type(4)));
typedef int v8i_t __attribute__((ext_vector_type(8)));
__device__ __forceinline__ v8i_t cat16(bf16x8 a, bf16x8 b) { const v4i_t x = __builtin_bit_cast(v4i_t, a), y = __builtin_bit_cast(v4i_t, b); return __builtin_shufflevector(x, y, 0, 1, 2, 3, 4, 5, 6, 7); }
__device__ __forceinline__ void mfma_fp8(f32x4& acc, v8i_t a, v8i_t b, int sa, int sb) {
    asm volatile("v_mfma_scale_f32_16x16x128_f8f6f4 %0, %1, %2, %0, %3, %4 op_sel_hi:[0,0,0]" : "+v"(acc) : "v"(a), "v"(b), "v"(sa), "v"(sb)); }
template <class Epi, class Sched, bool ALIGN_EPI, bool GATHER, bool FP8 = false>
__device__ __forceinline__ void gemm_phase(PG8_LAS unsigned char* lds, const int K, const Sched& S, const Epi& E) {
    const int tid = threadIdx.x, wid = __builtin_amdgcn_readfirstlane(tid >> 6), lane = tid & 63, wr = wid >> 2, wc = wid & 3, fr = lane & 15, fq = lane >> 4;
    const int RB = FP8 ? K : K * 2;
    const int nt = RB / 128;
    unsigned voffA[2], voffB[2]; int R0, C0;
    { stage_rc(tid * 16, R0, C0); const int Rb = Epi::PERM ? ((R0 & ~31) + perm32(R0 & 31)) : R0;
      voffA[0] = (unsigned)(R0 * RB + C0 * 2); voffB[0] = (unsigned)(Rb * RB + C0 * 2); voffA[1] = voffA[0] + 64u * (unsigned)RB; voffB[1] = voffB[0] + 64u * (unsigned)RB; }
    const size_t kstep = (size_t)(BK * 2);
    const size_t hstep = (size_t)HALF * RB;
    const unsigned ldsw = (unsigned)wid * 1024u;
    const int aoff = lds_byte(wr * 64 + fr, fq * 8), boff = lds_byte(wc * 32 + fr, fq * 8);
#define PG8_SA(b, h) (((b) * 2 + (h)) * HTB)
#define PG8_SB(b, h) ((4 + (b) * 2 + (h)) * HTB)
    const unsigned ldsu = (unsigned)(uintptr_t)lds + ldsw;
#define PG8_DMA_S(sbase, voff_, ldsaddr) do { unsigned _keep; asm volatile("s_mov_b32 %0, m0\n\ts_mov_b32 m0, %3\n\ts_nop 0\n\tglobal_load_lds_dwordx4 %2, %1\n\ts_mov_b32 m0, %0" : "=&s"(_keep) : "s"((const char*)(sbase)), "v"(voff_), "s"(ldsaddr) : "memory"); } while (0)
#define PG8_STAGE(bufoff, gbase, voff) do { _Pragma("unroll") for (int _i = 0; _i < 2; ++_i) { \
        if constexpr (FP8) PG8_DMA_S((const char*)(gbase) + (size_t)_i * 64 * RB, (voff)[0], ldsu + (unsigned)((bufoff) + _i * 8192)); \
        else __builtin_amdgcn_global_load_lds((const unsigned*)((const char*)(gbase) + (voff)[_i]), (PG8_LAS unsigned*)(lds + (bufoff) + ldsw + _i * 8192), 16, 0, 0); } } while (0)
#define PG8_STAGE_G(bufoff, gbase, voff) do { _Pragma("unroll") for (int _i = 0; _i < 2; ++_i) { \
        if constexpr (FP8) PG8_DMA_S((const char*)(gbase), (voff)[_i], ldsu + (unsigned)((bufoff) + _i * 8192)); \
        else __builtin_amdgcn_global_load_lds((const unsigned*)((const char*)(gbase) + (voff)[_i]), (PG8_LAS unsigned*)(lds + (bufoff) + ldsw + _i * 8192), 16, 0, 0); } } while (0)
#define PG8_STA_CUR(b, h, kptr) do { if constexpr (GATHER) { PG8_STAGE_G(PG8_SA(b, h), kptr, gAc[h]); } else { PG8_STAGE(PG8_SA(b, h), (kptr) + (h) * hstep, voffA); } } while (0)
#define PG8_GROW(slot_, h, i) ((unsigned)S.arow(slot_, (h) * HALF + R0 + 64 * (i)) * (unsigned)RB + (unsigned)(C0 * 2))
#define PG8_STA_SEL(b, h, kptr, sel) do { if constexpr (GATHER) { unsigned _vo[2] = {(sel) ? gAn[h][0] : gAc[h][0], (sel) ? gAn[h][1] : gAc[h][1]}; PG8_STAGE_G(PG8_SA(b, h), kptr, _vo); } \
        else { PG8_STAGE(PG8_SA(b, h), (kptr) + (h) * hstep, voffA); } } while (0)
#define PG8_LDA(dst, b, h) do { _Pragma("unroll") for (int m = 0; m < 4; ++m) _Pragma("unroll") for (int k = 0; k < 2; ++k) dst[m][k] = *(const PG8_LAS bf16x8*)(lds + PG8_SA(b, h) + aoff + m * 2048 + k * 1024); } while (0)
#define PG8_LDB(dst, b, h) do { _Pragma("unroll") for (int n = 0; n < 2; ++n) _Pragma("unroll") for (int k = 0; k < 2; ++k) dst[n][k] = *(const PG8_LAS bf16x8*)(lds + PG8_SB(b, h) + boff + n * 2048 + k * 1024); } while (0)
#define PG8_MMA(ai, bj, At, Bt) do { __builtin_amdgcn_s_setprio(1); _Pragma("unroll") for (int m = 0; m < 4; ++m) _Pragma("unroll") for (int n = 0; n < 2; ++n) { \
        if constexpr (FP8) mfma_fp8(acc[ai][bj][m][n], cat16(Bt[n][0], Bt[n][1]), cat16(At[m][0], At[m][1]), sclW, sclA); \
        else { _Pragma("unroll") for (int k = 0; k < 2; ++k) acc[ai][bj][m][n] = __builtin_amdgcn_mfma_f32_16x16x32_bf16(Bt[n][k], At[m][k], acc[ai][bj][m][n], 0, 0, 0); } } __builtin_amdgcn_s_setprio(0); } while (0)
#define PG8_WAIT_V(n) asm volatile("s_waitcnt vmcnt(" #n ")" ::: "memory")
#define PG8_WAIT_L(n) asm volatile("s_waitcnt lgkmcnt(" #n ")" ::: "memory")
#define PG8_BAR __builtin_amdgcn_s_barrier()
#define PG8_SCHED __builtin_amdgcn_sched_barrier(0)
    Unit cur, nxt; int ui = 0;
    if (!S.next(0, cur)) return;
    int sclW = 0, sclA = 0; if constexpr (FP8) { sclW = Epi::SCALE_W; sclA = Epi::SCALE_A; asm volatile("" : "+v"(sclW), "+v"(sclA)); }
    unsigned gAc[2][2], gAn[2][2];
#pragma unroll
    for (int h = 0; h < 2; ++h)
#pragma unroll
        for (int i = 0; i < 2; ++i) { gAc[h][i] = GATHER ? PG8_GROW(cur.slot, h, i) : 0u; gAn[h][i] = gAc[h][i]; }
    f32x4 acc[2][2][4][2];
#pragma unroll
    for (int a = 0; a < 2; ++a)
#pragma unroll
        for (int b = 0; b < 2; ++b)
#pragma unroll
            for (int m = 0; m < 4; ++m)
#pragma unroll
                for (int n = 0; n < 2; ++n) acc[a][b][m][n] = (f32x4){0.f, 0.f, 0.f, 0.f};
    bf16x8 At[4][2], B0[2][2], B1[2][2];
    const char* cA = uniform_ptr(cur.A); const char* cB = uniform_ptr(cur.B);
    PG8_STAGE(PG8_SB(0, 0), cB, voffB); PG8_STAGE(PG8_SB(0, 1), cB + hstep, voffB); PG8_STA_CUR(0, 0, cA); PG8_STA_CUR(0, 1, cA);
    if (wr == 1) PG8_BAR;
    PG8_WAIT_V(2); PG8_BAR;
    PG8_STAGE(PG8_SB(1, 0), cB + kstep, voffB); PG8_STA_CUR(1, 0, cA + kstep); PG8_STAGE(PG8_SB(1, 1), cB + hstep + kstep, voffB);
    PG8_WAIT_V(6); PG8_BAR;
    for (;;) {
        const bool has_next = S.next(ui + 1, nxt);
        if constexpr (GATHER) { if (has_next) {
#pragma unroll
            for (int h = 0; h < 2; ++h)
#pragma unroll
                for (int i = 0; i < 2; ++i) gAn[h][i] = PG8_GROW(nxt.slot, h, i); } }
        const char* nA = uniform_ptr(has_next ? nxt.A : cA); const char* nB = uniform_ptr(has_next ? nxt.B : cB);
#pragma clang loop unroll(disable)
        for (int t = 0; t < nt; t += 2) {
            const bool last = (t == nt - 2);
            const bool seln = last && has_next;
            const char* a1 = cA + (size_t)(t + 1) * kstep;
            const char* a2 = last ? nA : cA + (size_t)(t + 2) * kstep; const char* b2 = last ? nB : cB + (size_t)(t + 2) * kstep;
            const char* a3 = a2 + kstep; const char* b3 = b2 + kstep;
            PG8_LDB(B0, 0, 0); PG8_LDB(B1, 0, 1); PG8_SCHED; PG8_LDA(At, 0, 0); PG8_STA_CUR(1, 1, a1);
            PG8_WAIT_V(8); PG8_WAIT_L(0); PG8_BAR; PG8_MMA(0, 0, At, B0); PG8_MMA(0, 1, At, B1); PG8_BAR; PG8_SCHED;
            PG8_LDA(At, 0, 1); PG8_STAGE(PG8_SB(0, 0), b2, voffB); PG8_STAGE(PG8_SB(0, 1), b2 + hstep, voffB); PG8_STA_SEL(0, 0, a2, seln);
            PG8_WAIT_V(8); PG8_WAIT_L(0); PG8_BAR; PG8_MMA(1, 0, At, B0); PG8_MMA(1, 1, At, B1); PG8_BAR; PG8_SCHED;
            PG8_LDB(B0, 1, 0); PG8_LDB(B1, 1, 1); PG8_SCHED; PG8_LDA(At, 1, 0); PG8_STA_SEL(0, 1, a2, seln);
            PG8_WAIT_V(8); PG8_WAIT_L(0); PG8_BAR; PG8_MMA(0, 0, At, B0); PG8_MMA(0, 1, At, B1); PG8_BAR; PG8_SCHED;
            PG8_LDA(At, 1, 1); PG8_STAGE(PG8_SB(1, 0), b3, voffB); PG8_STAGE(PG8_SB(1, 1), b3 + hstep, voffB); PG8_STA_SEL(1, 0, a3, seln);
            PG8_WAIT_V(8); PG8_WAIT_L(0); PG8_BAR; PG8_MMA(1, 0, At, B0); PG8_MMA(1, 1, At, B1); PG8_BAR; PG8_SCHED;
        }
        if constexpr (ALIGN_EPI) { if (wr == 0) PG8_BAR; }
        if constexpr (FP8) asm volatile("s_nop 15\n\ts_nop 7" ::: "memory");
        E(acc, cur, wr, wc, fr, fq);
        if (!has_next) break;
#pragma unroll
        for (int a = 0; a < 2; ++a)
#pragma unroll
            for (int b = 0; b < 2; ++b)
#pragma unroll
                for (int m = 0; m < 4; ++m)
#pragma unroll
                    for (int n = 0; n < 2; ++n) acc[a][b][m][n] = (f32x4){0.f, 0.f, 0.f, 0.f};
        cur = nxt; cA = nA; cB = nB; ++ui;
        if constexpr (GATHER) {
#pragma unroll
            for (int h = 0; h < 2; ++h)
#pragma unroll
                for (int i = 0; i < 2; ++i) gAc[h][i] = gAn[h][i]; }
        if constexpr (ALIGN_EPI) { if (wr == 1) PG8_BAR; }
    }
    PG8_WAIT_V(0);
    if constexpr (!ALIGN_EPI) { if (wr == 0) PG8_BAR; }
    PG8_BAR;
#undef PG8_SA
#undef PG8_SB
#undef PG8_STAGE
#undef PG8_STAGE_G
#undef PG8_DMA_S
#undef PG8_STA_CUR
#undef PG8_STA_SEL
#undef PG8_GROW
#undef PG8_LDA
#undef PG8_LDB
#undef PG8_MMA
#undef PG8_WAIT_V
#undef PG8_WAIT_L
#undef PG8_BAR
#undef PG8_SCHED
}
}

#ifndef REPMASK
#define REPMASK 0
#endif
#ifdef CV_LATE
#define CV_SPLIT CV_DENSE
#endif
namespace mk {
using pg8::bf16_t; using pg8::f32x4; using pg8::f32x2; using pg8::u32x4; using pg8::u32x2; using pg8::Unit; using pg8::cvt_pk_bf16; using pg8::bf_lo; using pg8::bf_hi; using pg8::sigm;
#define GAS __attribute__((address_space(1)))
#define LAS __attribute__((address_space(3)))
typedef GAS unsigned gu32;
#define RLX_AGENT __ATOMIC_RELAXED, __HIP_MEMORY_SCOPE_AGENT
#define LDS_WAIT() asm volatile("s_waitcnt lgkmcnt(0)" ::: "memory")
#define VM_WAIT() asm volatile("s_waitcnt vmcnt(0)" ::: "memory")

constexpr int NWAVES = 8;
constexpr int S = 16384, D = 1024, NE = 32, FF = 1024;
constexpr int ZP = 4352;
constexpr int C_QA = 0, C_KA = 512, C_VA = 640, C_QB = 768, C_KB = 1280, C_VB = 1792, C_GA = 2304, C_GB = 3328;
constexpr int W_FB = 2304;
constexpr int DIN = 4360;
constexpr float EPS = 1e-5f;
constexpr float LOG2E = 1.4426950408889634f;
constexpr float QSCALE = 0.125f * LOG2E;
constexpr int MAXSLOT = 65536 + 32 * 256;

constexpr size_t MiB = 1u << 20;
constexpr size_t WS_CTL = 0, CTL_ZERO_BYTES = 1 * MiB;
constexpr size_t WS_MOD = 1 * MiB;
constexpr size_t WS_TAB = WS_MOD + 32768;
constexpr size_t WS_BGL = WS_TAB + 8192;
constexpr size_t WS_LOGF = 2 * MiB;
constexpr size_t WS_CUM = 3 * MiB;
constexpr size_t WS_SEL = 4 * MiB;
constexpr size_t WS_LIST = 5 * MiB;
constexpr size_t WS_WIN = 8 * MiB;
constexpr size_t WS_WPA = 17 * MiB, WS_WPB = 18 * MiB;
constexpr size_t WS_WO = 19 * MiB;
constexpr size_t WS_U = 22 * MiB;
constexpr size_t WS_Z = 54 * MiB;
constexpr size_t WS_YAB = 190 * MiB;
constexpr size_t WS_TMP = 222 * MiB;
constexpr size_t WS_MRG = 254 * MiB;
constexpr size_t WS_X1 = 286 * MiB;
constexpr size_t WS_WE1 = 350 * MiB;
constexpr size_t WS_WE2 = 478 * MiB;
constexpr size_t WS_ACT = 542 * MiB;
constexpr size_t WS_Y = 686 * MiB;
constexpr size_t WS_END = 830 * MiB;
constexpr int CW_TMO = 0;
constexpr int CW_CNT = 64;
constexpr int CW_MODCNT = 192;
constexpr int CW_QUEUE = 128;
constexpr int CW_BAR = 4096;

constexpr int RING_OFF = 0, RING_BYTES = 131072;
constexpr int ROWTAB_OFF = 135168, ROWTAB_UNITS = 12;
constexpr int LDSCTL_OFF = 162816, MISC_OFF = LDSCTL_OFF + 320;
constexpr int LDS_BYTES = 163840;
static_assert(ROWTAB_OFF + ROWTAB_UNITS * 1024 <= LDSCTL_OFF && MISC_OFF + 128 <= LDS_BYTES, "LDS map");

__device__ __forceinline__ unsigned f2bf(float f) { unsigned u = __builtin_bit_cast(unsigned, f); return (u + 0x7fffu + ((u >> 16) & 1u)) >> 16; }
typedef float f32x2_t __attribute__((ext_vector_type(2))); typedef __bf16 bf16x2_t __attribute__((ext_vector_type(2)));
__device__ __forceinline__ unsigned pk2(float lo, float hi) { const f32x2_t v = {lo, hi}; const bf16x2_t b = __builtin_convertvector(v, bf16x2_t); return __builtin_bit_cast(unsigned, b); }
__device__ __forceinline__ unsigned pk_fp8x4(float a, float b, float c, float d) { int w = __builtin_amdgcn_cvt_pk_fp8_f32(a, b, 0, false); w = __builtin_amdgcn_cvt_pk_fp8_f32(c, d, w, true); return (unsigned)w; }
constexpr float W_SCALE = 64.0f, ACT_SCALE = 8.0f;
__device__ __forceinline__ float wave_sum(float v) {
#pragma unroll
    for (int o = 1; o < 64; o <<= 1) v += __shfl_xor(v, o);
    return v;
}

__device__ __forceinline__ int wave_min_i(int v) {
#pragma unroll
    for (int o = 1; o < 64; o <<= 1) { const int t = __shfl_xor(v, o); v = t < v ? t : v; }
    return v;
}
__device__ __forceinline__ float wave_max(float v) {
#pragma unroll
    for (int o = 1; o < 64; o <<= 1) v = fmaxf(v, __shfl_xor(v, o));
    return v;
}

#define XB_TMO      128
#define XB_XCNT(j)  (256  + 64 * (j))
#define XB_XSUB(j)  (1280 + 64 * (j))
#define XB_XGEN(j)  (2304 + 64 * (j))
#define XB_TOP      3328
#define XB_TOPGEN   3392
#define XCD_BAR_WORDS 3456
#define XB_SPIN_CAP (1u << 18)

__device__ __forceinline__ unsigned xb_ld(unsigned* p)              { return __hip_atomic_load(p, __ATOMIC_RELAXED, __HIP_MEMORY_SCOPE_AGENT); }
__device__ __forceinline__ unsigned xb_add(unsigned* p, unsigned v) { return __hip_atomic_fetch_add(p, v, __ATOMIC_RELAXED, __HIP_MEMORY_SCOPE_AGENT); }
__device__ __forceinline__ unsigned xb_xcc_id() { return (unsigned)__builtin_amdgcn_s_getreg((3 << 11) | 20) & 0xFu; }
#define XB_SPIN(cond, bar) do { unsigned _sp = 0; while (cond) { __builtin_amdgcn_s_sleep(1); \
    if ((++_sp & 255u) == 0u) { if (xb_ld(&(bar)[XB_TMO])) break; if (_sp > XB_SPIN_CAP) { atomicAdd(&(bar)[XB_TMO], 1u); break; } } } } while (0)

struct XcdBarrier {
    unsigned* bar; unsigned x;
    volatile LAS unsigned* st;
};

__device__ __forceinline__ XcdBarrier xcd_barrier_post(unsigned* bar, volatile LAS unsigned* st) {
    XcdBarrier b; b.bar = bar; b.x = xb_xcc_id(); b.st = st;
    if (threadIdx.x == 0) (void)xb_add(&bar[XB_XCNT(b.x)], 1u);
    return b;
}
__device__ __forceinline__ void xcd_barrier_complete(unsigned* bar, unsigned x, unsigned& nloc, unsigned& nx) {
    const unsigned G = gridDim.x * gridDim.y * gridDim.z;
    unsigned sum, cnt, mine, sp = 0u;
    for (;;) {
        sum = 0u; cnt = 0u; mine = 0u;
#pragma unroll
        for (unsigned j = 0; j < 16; ++j) { const unsigned c = xb_ld(&bar[XB_XCNT(j)]); sum += c; cnt += (c > 0u) ? 1u : 0u; mine = (j == x) ? c : mine; }
        if (sum == G) break;
        __builtin_amdgcn_s_sleep(1);
        if ((++sp & 255u) == 0u) { if (xb_ld(&bar[XB_TMO])) break; if (sp > XB_SPIN_CAP) { atomicAdd(&bar[XB_TMO], 1u); break; } }
    }
    nloc = mine > 0u ? mine : 1u; nx = cnt > 0u ? cnt : 1u;
}

__device__ __forceinline__ void xcd_barrier(const XcdBarrier& b) {
    asm volatile("s_waitcnt vmcnt(0)" ::: "memory");
    __syncthreads();
    if (threadIdx.x == 0) {
        unsigned* bar = b.bar;
        __builtin_amdgcn_s_waitcnt(0);
        unsigned nloc = b.st[0], nx = b.st[1];
        if (nloc == 0u) { xcd_barrier_complete(bar, b.x, nloc, nx); b.st[0] = nloc; b.st[1] = nx; }
        const unsigned old = xb_add(&bar[XB_XSUB(b.x)], 1u);
        const unsigned gen = old / nloc;
        if (old + 1u == (gen + 1u) * nloc) {
            __builtin_amdgcn_fence(__ATOMIC_RELEASE, "agent");
            asm volatile("s_waitcnt vmcnt(0)" ::: "memory");
            const unsigned og = xb_add(&bar[XB_TOP], 1u);
            const unsigned tg = og / nx;
            if (og + 1u == (tg + 1u) * nx) xb_add(&bar[XB_TOPGEN], 1u);
            else XB_SPIN(xb_ld(&bar[XB_TOPGEN]) == tg, bar);
            __builtin_amdgcn_fence(__ATOMIC_ACQUIRE, "agent");
            xb_add(&bar[XB_XGEN(b.x)], 1u);
            asm volatile("s_waitcnt vmcnt(0)" ::: "memory");
        } else {
            XB_SPIN(xb_ld(&bar[XB_XGEN(b.x)]) == gen, bar);
            __builtin_amdgcn_fence(__ATOMIC_ACQUIRE, "agent");
            asm volatile("s_waitcnt vmcnt(0)" ::: "memory");
        }
    }
    __syncthreads();
}

struct Frame {
    LAS unsigned char* lds;
    volatile LAS unsigned* MISC;
    gu32* ctl;
    int tid, lane, wave, vcu, G;
};

__device__ __forceinline__ void p0_small(Frame& F, const float* c, const float* w_ada, const float* b_ada, const float* rel, const float* b_e1, float* mod, float* tab, float* bgl) {
    LAS float* red = (LAS float*)(F.lds);
    for (int cg = blockIdx.x; cg < 256; cg += F.G) {
        const int col = F.tid % 24, kg = F.tid / 24;
        float acc = 0.f;
        if (kg < 21) { for (int k = kg; k < D; k += 21) { const float cv = c[k]; const float s = cv / (1.f + expf(-cv)); acc += s * w_ada[(size_t)k * 6144 + cg * 24 + col]; } red[kg * 24 + col] = acc; }
        __syncthreads();
        if (F.tid < 24) { float t = 0.f; for (int i = 0; i < 21; ++i) t += red[i * 24 + F.tid]; mod[cg * 24 + F.tid] = t + b_ada[cg * 24 + F.tid]; }
        __syncthreads();
        if (F.tid == 0) { __builtin_amdgcn_fence(__ATOMIC_RELEASE, "agent"); asm volatile("s_waitcnt vmcnt(0)" ::: "memory");
            __hip_atomic_fetch_add((unsigned*)(F.ctl + CW_MODCNT), 1u, __ATOMIC_RELAXED, __HIP_MEMORY_SCOPE_AGENT); }
    }
    if (blockIdx.x == 0) {
        for (int i = F.tid; i < 1024; i += NWAVES * 64) { const int h = i >> 7, n = i & 127; int bk;
            if (n < 16) bk = n; else { const int lg = 16 + (int)(logf((float)n / 16.f) / logf(8.f) * 16.f); bk = lg < 31 ? lg : 31; }
            tab[h * 128 + n] = rel[bk * 8 + h] * LOG2E; }
    }
    for (int i = blockIdx.x * (NWAVES * 64) + F.tid; i < NE * 2048; i += F.G * NWAVES * 64) {
        const int e = i >> 11, j = i & 2047; bgl[e * 2048 + (j & 1) * 1024 + (j >> 1)] = b_e1[i]; }
}

__device__ __forceinline__ void wait_mod(Frame& F) {
    if (F.tid == 0) { unsigned sp = 0;
        while (__hip_atomic_load((unsigned*)(F.ctl + CW_MODCNT), __ATOMIC_RELAXED, __HIP_MEMORY_SCOPE_AGENT) < 256u) { __builtin_amdgcn_s_sleep(2); if (++sp > (1u << 22)) { __hip_atomic_store((unsigned*)(F.ctl + CW_TMO), 1u, __ATOMIC_RELAXED, __HIP_MEMORY_SCOPE_AGENT); break; } }
        __builtin_amdgcn_fence(__ATOMIC_ACQUIRE, "agent"); asm volatile("s_waitcnt vmcnt(0)" ::: "memory"); }
    __syncthreads();
}
__device__ __forceinline__ void p1_rows(Frame& F, const float* x, const float* g, const float* mod, const float* w_in, const float* b_forget, bf16_t* U, float* logf_out) {
    LAS float* wf = (LAS float*)F.lds;
    for (int i = F.tid; i < 2048; i += NWAVES * 64) { const int k = i >> 1, hh = i & 1; const f32x4 t = *(const f32x4*)(w_in + (size_t)k * DIN + W_FB + hh * 4);
        wf[(hh * 4 + 0) * 1024 + k] = t.x; wf[(hh * 4 + 1) * 1024 + k] = t.y; wf[(hh * 4 + 2) * 1024 + k] = t.z; wf[(hh * 4 + 3) * 1024 + k] = t.w; }
    __syncthreads();
    f32x4 gv[4], sc1[4], sh[4];
#pragma unroll
    for (int j = 0; j < 4; ++j) { const int o = 4 * F.lane + 256 * j; gv[j] = *(const f32x4*)(g + o); sc1[j] = *(const f32x4*)(mod + 1024 + o) + 1.0f; sh[j] = *(const f32x4*)(mod + o); }
    const int gw = F.vcu * NWAVES + F.wave, NGW = F.G * NWAVES;
    const float bfv = b_forget[F.lane & 7];
    for (int m = gw; m < S; m += NGW) {
        const GAS f32x4* xr = (const GAS f32x4*)(x + (size_t)m * D) + F.lane;
        f32x4 v[4]; float ss = 0.f;
#pragma unroll
        for (int j = 0; j < 4; ++j) { v[j] = xr[64 * j]; ss += (v[j].x * v[j].x + v[j].y * v[j].y) + (v[j].z * v[j].z + v[j].w * v[j].w); }
        const float r = 1.0f / sqrtf(wave_sum(ss) * (1.f / D) + EPS);
        float fb[8];
#pragma unroll
        for (int h = 0; h < 8; ++h) fb[h] = 0.f;
        GAS unsigned long long* o8 = (GAS unsigned long long*)(U + (size_t)m * D) + F.lane;
#pragma unroll
        for (int j = 0; j < 4; ++j) {
            v[j] = v[j] * r * gv[j] * sc1[j] + sh[j];
            o8[64 * j] = (unsigned long long)pk2(v[j].x, v[j].y) | ((unsigned long long)pk2(v[j].z, v[j].w) << 32);
#pragma unroll
            for (int h = 0; h < 8; ++h) { const f32x4 w4 = *(const LAS f32x4*)(wf + h * 1024 + 4 * F.lane + 256 * j); fb[h] += (v[j].x * w4.x + v[j].y * w4.y) + (v[j].z * w4.z + v[j].w * w4.w); }
        }
#pragma unroll
        for (int h = 0; h < 8; ++h) fb[h] = wave_sum(fb[h]);
        float mine = fb[0];
#pragma unroll
        for (int h = 1; h < 8; ++h) mine = ((F.lane & 7) == h) ? fb[h] : mine;
        if (F.lane < 8) { const float xv = mine + bfv; logf_out[(size_t)m * 8 + F.lane] = fminf(xv, 0.f) - log1pf(expf(-fabsf(xv))); }
    }
    __syncthreads();
}
template <bool IL>
__device__ __forceinline__ void tr_item64(const float* W, int ldw, int sc0, int k0, bf16_t* WT, int K, int dr0, LAS unsigned char* scr, int lane) {
    const int r = lane >> 4, c = lane & 15;
    const float* src = W + (size_t)(k0 + 16 * r) * ldw + sc0 + 4 * c;
    f32x4 v[16];
#pragma unroll
    for (int i = 0; i < 16; ++i) v[i] = *(const f32x4*)(src + (size_t)i * ldw);
#pragma unroll
    for (int j = 0; j < 4; ++j) { u32x4 w0, w1;
        w0.x = cvt_pk_bf16(v[0][j], v[1][j]); w0.y = cvt_pk_bf16(v[2][j], v[3][j]); w0.z = cvt_pk_bf16(v[4][j], v[5][j]); w0.w = cvt_pk_bf16(v[6][j], v[7][j]);
        w1.x = cvt_pk_bf16(v[8][j], v[9][j]); w1.y = cvt_pk_bf16(v[10][j], v[11][j]); w1.z = cvt_pk_bf16(v[12][j], v[13][j]); w1.w = cvt_pk_bf16(v[14][j], v[15][j]);
        LAS unsigned char* d = scr + (4 * c + j) * 144 + r * 32; *(LAS u32x4*)d = w0; *(LAS u32x4*)(d + 16) = w1; }
    LDS_WAIT(); asm volatile("" ::: "memory");
#pragma unroll
    for (int q = 0; q < 8; ++q) { const int n = (lane >> 3) + 8 * q, ch = lane & 7; const u32x4 w = *(const LAS u32x4*)(scr + n * 144 + ch * 16);
        const int drow = IL ? dr0 + (n >> 1) + 128 * (n & 1) : dr0 + n;
        *(GAS u32x4*)(WT + (size_t)drow * K + k0 + 8 * ch) = w; }
    LDS_WAIT(); asm volatile("" ::: "memory");
}
template <bool IL>
__device__ __forceinline__ void tr_item_fp8(const float* W, int ldw, int sc0, int k0, unsigned char* WT, int K, int dr0, LAS unsigned char* scr, int lane) {
    const int r = lane >> 3, c = lane & 7;
    const float* src = W + (size_t)(k0 + 16 * r) * ldw + sc0 + 4 * c;
    f32x4 v[16];
#pragma unroll
    for (int i = 0; i < 16; ++i) v[i] = *(const f32x4*)(src + (size_t)i * ldw) * W_SCALE;
#pragma unroll
    for (int j = 0; j < 4; ++j) { u32x4 w;
        w.x = pk_fp8x4(v[0][j], v[1][j], v[2][j], v[3][j]); w.y = pk_fp8x4(v[4][j], v[5][j], v[6][j], v[7][j]); w.z = pk_fp8x4(v[8][j], v[9][j], v[10][j], v[11][j]); w.w = pk_fp8x4(v[12][j], v[13][j], v[14][j], v[15][j]);
        *(LAS u32x4*)(scr + (4 * c + j) * 144 + r * 16) = w; }
    LDS_WAIT(); asm volatile("" ::: "memory");
#pragma unroll
    for (int q = 0; q < 4; ++q) { const int n = (lane >> 3) + 8 * q, ch = lane & 7; const u32x4 w = *(const LAS u32x4*)(scr + n * 144 + ch * 16);
        const int drow = IL ? dr0 + (n >> 1) + 128 * (n & 1) : dr0 + n;
        *(GAS u32x4*)(WT + (size_t)drow * K + k0 + 16 * ch) = w; }
    LDS_WAIT(); asm volatile("" ::: "memory");
}
constexpr int CV_IN = 16 * (ZP / 64), CV_P = 8 * 16, CV_O = 16 * 16, CV_DENSE = CV_IN + 2 * CV_P + CV_O, CV_E1 = NE * 8 * 64, CV_E2 = NE * 8 * 32, CV_TOTAL = CV_DENSE + CV_E1 + CV_E2;
struct ConvPtrs { const float *w_in, *w_pa, *w_pb, *w_o, *w_e1, *w_e2; bf16_t *Win, *Wpa, *Wpb, *Wo; unsigned char *We1, *We2; };
__device__ __forceinline__ void conv_item(const ConvPtrs& P, int r, LAS unsigned char* scr, int lane) {
    if (r < CV_IN) { const int kb = r / (ZP / 64), nb = r % (ZP / 64); const int sc0 = 64 * nb + (64 * nb >= W_FB ? 8 : 0); tr_item64<false>(P.w_in, DIN, sc0, 64 * kb, P.Win, D, 64 * nb, scr, lane); return; } r -= CV_IN;
    if (r < CV_P) { tr_item64<false>(P.w_pa, D, 64 * (r & 15), 64 * (r >> 4), P.Wpa, 512, 64 * (r & 15), scr, lane); return; } r -= CV_P;
    if (r < CV_P) { tr_item64<false>(P.w_pb, D, 64 * (r & 15), 64 * (r >> 4), P.Wpb, 512, 64 * (r & 15), scr, lane); return; } r -= CV_P;
    if (r < CV_O) { tr_item64<false>(P.w_o, D, 64 * (r & 15), 64 * (r >> 4), P.Wo, D, 64 * (r & 15), scr, lane); return; } r -= CV_O;
    if (r < CV_E1) { const int e = r >> 9, kb = (r & 511) >> 6, grp = r & 63;
        tr_item_fp8<true>(P.w_e1 + (size_t)e * D * 2048, 2048, 32 * grp, 128 * kb, P.We1 + (size_t)e * 2048 * D, D, 256 * (grp >> 3) + 16 * (grp & 7), scr, lane); return; } r -= CV_E1;
    { const int e = r >> 8, kb = (r & 255) >> 5, nb = r & 31; tr_item_fp8<false>(P.w_e2 + (size_t)e * FF * D, D, 32 * nb, 128 * kb, P.We2 + (size_t)e * D * FF, FF, 32 * nb, scr, lane); }
}
__device__ __forceinline__ void conv_range(Frame& F, const ConvPtrs& P, int lo, int hi) {
    LAS unsigned char* scr = F.lds + F.wave * 9216;
    for (int it = lo + F.vcu * NWAVES + F.wave; it < hi; it += F.G * NWAVES) conv_item(P, it, scr, F.lane);
}

struct EpiInProj {
    static constexpr bool PERM = true;
    bf16_t* O;
    __device__ __forceinline__ void operator()(const f32x4 (&acc)[2][2][4][2], const Unit& u, int wr, int wc, int fr, int fq) const {
        const int row0 = u.pm * 256 + wr * 64 + fr, col0 = u.pn * 256 + wc * 32 + 8 * fq;
        const float sc = (u.pn < 2 || u.pn == 3 || u.pn == 4) ? QSCALE : 1.0f;
#pragma unroll
        for (int ai = 0; ai < 2; ++ai)
#pragma unroll
            for (int m = 0; m < 4; ++m) { bf16_t* rowp = O + (size_t)(row0 + ai * 128 + m * 16) * ZP + col0;
#pragma unroll
                for (int bj = 0; bj < 2; ++bj) { const f32x4 v0 = acc[ai][bj][m][0] * sc, v1 = acc[ai][bj][m][1] * sc;
                    u32x4 w; w.x = cvt_pk_bf16(v0[0], v0[1]); w.y = cvt_pk_bf16(v0[2], v0[3]); w.z = cvt_pk_bf16(v1[0], v1[1]); w.w = cvt_pk_bf16(v1[2], v1[3]);
                    *(u32x4*)(rowp + bj * 128) = w; } }
    }
};

__device__ __forceinline__ void p2b_cum(Frame& F, const float* logf_in, float* cum, int b0) {
    if ((int)blockIdx.x >= b0 && (int)blockIdx.x < b0 + 8) {
        const int h = (int)blockIdx.x - b0; LAS float* part = (LAS float*)F.lds;
        float lf[32]; float s = 0.f; const int t0 = F.tid * 32;
#pragma unroll
        for (int i = 0; i < 32; ++i) { lf[i] = logf_in[(size_t)(t0 + i) * 8 + h]; s += lf[i]; }
        part[F.tid] = s; __syncthreads();
        for (int o = 1; o < NWAVES * 64; o <<= 1) { const float v = (F.tid >= o) ? part[F.tid - o] : 0.f; __syncthreads(); part[F.tid] += v; __syncthreads(); }
        float run = part[F.tid] - s;
#pragma unroll
        for (int i = 0; i < 32; ++i) { run += lf[i]; cum[(size_t)h * S + t0 + i] = run * LOG2E; }
        __syncthreads();
    }
}

__device__ __forceinline__ void p2b_stats(Frame& F, const bf16_t* Z, float* QN, float* DG, float* KN) {
    const int gw = F.vcu * NWAVES + F.wave, NGW = F.G * NWAVES;
    for (int it = gw; it < 8 * (S / 64); it += NGW) {
        const int h = it >> 8, T = it & 255, t = 64 * T + F.lane;
        const u32x4* qp = (const u32x4*)(Z + (size_t)t * ZP + C_QB + h * 64); const u32x4* kp = (const u32x4*)(Z + (size_t)t * ZP + C_KB + h * 64);
        float qq = 0.f, kk = 0.f, qk = 0.f;
#pragma unroll
        for (int i = 0; i < 8; ++i) { const u32x4 a = qp[i], b = kp[i];
#pragma unroll
            for (int j = 0; j < 4; ++j) { const float a0 = bf_lo(a[j]), a1 = bf_hi(a[j]), b0 = bf_lo(b[j]), b1 = bf_hi(b[j]); qq += a0 * a0 + a1 * a1; kk += b0 * b0 + b1 * b1; qk += a0 * b0 + a1 * b1; } }
        QN[(size_t)h * S + t] = sqrtf(qq); DG[(size_t)h * S + t] = qk;
        const float km = wave_max(kk);
        if (F.lane == 0) KN[h * 256 + T] = sqrtf(km);
    }
}

namespace at {
typedef short bf16x8 __attribute__((ext_vector_type(8)));
typedef short s16x4 __attribute__((ext_vector_type(4)));
typedef short v4i16_t __attribute__((ext_vector_type(4)));
typedef float f32x16 __attribute__((ext_vector_type(16)));
constexpr int NBUF = 4, KBUF = 0, VBUF = NBUF * 8192, CBUF = 2 * NBUF * 8192  , BTAB = CBUF + NBUF * 2048  , QWORD = BTAB + 512;
__device__ __forceinline__ void glds16(const void* gsrc, unsigned lds_dst) { unsigned keep;
    asm volatile("s_mov_b32 %0, m0\n\ts_mov_b32 m0, %2\n\ts_nop 0\n\tglobal_load_lds_dwordx4 %1, off\n\ts_mov_b32 m0, %0" : "=&s"(keep) : "v"(gsrc), "s"(lds_dst) : "memory"); }
__device__ __forceinline__ void glds4(const void* gsrc, unsigned lds_dst) { unsigned keep;
    asm volatile("s_mov_b32 %0, m0\n\ts_mov_b32 m0, %2\n\ts_nop 0\n\tglobal_load_lds_dword %1, off\n\ts_mov_b32 m0, %0" : "=&s"(keep) : "v"(gsrc), "s"(lds_dst) : "memory"); }
#define AT_WAIT_BAR(N) asm volatile("s_waitcnt vmcnt(" #N ") lgkmcnt(0)\n\ts_barrier" ::: "memory")
__device__ __forceinline__ int crow(int r, int hi) { return (r & 3) + 8 * (r >> 2) + 4 * hi; }
__device__ __forceinline__ s16x4 vtr(const LAS char* p) { return __builtin_bit_cast(s16x4, __builtin_amdgcn_ds_read_tr16_b64_v4i16((LAS v4i16_t*)p)); }

constexpr float FOX_THR = 44.0f;
template <bool FOX>
__device__ __forceinline__ void attn_unit(Frame& F, int h, int qb, const bf16_t* Z, const float* cum, const float* tab, float sinkL2, const float* QN, const float* DG, const float* KN, bf16_t* Y) {
    const int lane = F.lane, r32 = lane & 31, hi = lane >> 5, wid = F.wave;
    const int q0 = qb * 256, qw0 = q0 + wid * 32, qrow = qw0 + r32;
    const int cq = FOX ? C_QB + h * 64 : C_QA + h * 64;
    const int ck = FOX ? C_KB + h * 64 : C_KA + (h >> 2) * 64;
    const int cv = FOX ? C_VB + h * 64 : C_VA + (h >> 2) * 64;
    const int tlast = (q0 + 255) >> 6;
    const int wlast = (qw0 + 31) >> 6;
    int tfirst = (q0 >> 6) - 2 > 0 ? (q0 >> 6) - 2 : 0;
    int wfirst = (qw0 - 127 > 0 ? qw0 - 127 : 0) >> 6;
    const unsigned lds0 = (unsigned)(uintptr_t)F.lds;
    const LAS char* L = (const LAS char*)F.lds;
    asm volatile("s_waitcnt vmcnt(0)" ::: "memory");
    if (!FOX) { if (F.tid < 128) ((LAS float*)(F.lds + BTAB))[F.tid] = tab[h * 128 + F.tid]; }
    bf16x8 qr[4];
#pragma unroll
    for (int d0 = 0; d0 < 4; ++d0) qr[d0] = *(const bf16x8*)(Z + (size_t)qrow * ZP + cq + d0 * 16 + hi * 8);
    const float ci = FOX ? cum[(size_t)h * S + qrow] : 0.f;
    const bf16_t* ksrc = Z + (size_t)lane * ZP + ck + wid * 8;
    const bf16_t* vsrc = Z + (size_t)(16 * (wid & 3) + (lane >> 2)) * ZP + cv + (wid >> 2) * 32 + (lane & 3) * 8;
    const float* csrc = cum + (size_t)h * S + lane;
    const unsigned kdst = lds0 + KBUF + wid * 1024, vdst = lds0 + VBUF + wid * 1024, cdst = lds0 + CBUF + wid * 256;
#define AT_ISSUE(t, b) do { glds16(ksrc + (size_t)(t) * 64 * ZP, (unsigned)__builtin_amdgcn_readfirstlane(kdst + (b) * 8192)); glds16(vsrc + (size_t)(t) * 64 * ZP, (unsigned)__builtin_amdgcn_readfirstlane(vdst + (b) * 8192)); \
        if (FOX) glds4(csrc + (size_t)(t) * 64, (unsigned)__builtin_amdgcn_readfirstlane(cdst + (b) * 2048)); } while (0)
    float m = FOX ? 0.f : sinkL2, l = FOX ? 0.f : (hi == 0 ? 1.f : 0.f), cinit = ci - m;
    bool first = FOX;
    f32x16 o[2]; o[0] = f32x16{}; o[1] = f32x16{};
#define AT_TILE(i_) ((tlast - (i_)) > tfirst ? (tlast - (i_)) : tfirst)
    AT_ISSUE(tlast, 0); AT_ISSUE(tlast - 1, 1); AT_ISSUE(tlast - 2, 2);
    if (FOX) {
        volatile LAS int* red = (volatile LAS int*)(F.lds + QWORD + 64);
        const size_t o_ = (size_t)h * S + qrow;
        const float qn = wave_max(QN[o_]), ev = wave_max(ci - DG[o_]);
        int myt = q0 >> 6;
        for (int T = F.lane; T < (q0 >> 6); T += 64) { const float ub = qn * KN[h * 256 + T] - cum[(size_t)h * S + 64 * T + 63] + ev; if (!(ub < -(FOX_THR + 1.0f))) myt = T < myt ? T : myt; }
        myt = wave_min_i(myt);
        if (F.lane == 0) red[F.wave] = myt;
        __syncthreads();
        int tf = red[0];
#pragma unroll
        for (int w = 1; w < 8; ++w) { const int t_ = red[w]; tf = t_ < tf ? t_ : tf; }
        tfirst = tf; wfirst = myt;
    }
    for (int t = tlast, i = 0; t >= tfirst; --t, ++i) {
        const int b = i & 3;
        if (FOX) AT_WAIT_BAR(6); else AT_WAIT_BAR(4);
        AT_ISSUE(AT_TILE(i + 3), (i + 3) & 3);
        if (t >= wfirst && t <= wlast) {
            const LAS char* Kb = L + KBUF + b * 8192; const LAS char* Vb = L + VBUF + b * 8192;
            f32x16 p0, p1;
#pragma unroll
            for (int r = 0; r < 16; ++r) { p0[r] = cinit; p1[r] = cinit; }
#pragma unroll
            for (int d0 = 0; d0 < 4; ++d0) {
                const bf16x8 a0 = *(const LAS bf16x8*)(Kb + (2 * d0 + hi) * 1024 + r32 * 16);
                const bf16x8 a1 = *(const LAS bf16x8*)(Kb + (2 * d0 + hi) * 1024 + r32 * 16 + 512);
                p0 = __builtin_amdgcn_mfma_f32_32x32x16_bf16(a0, qr[d0], p0, 0, 0, 0);
                p1 = __builtin_amdgcn_mfma_f32_32x32x16_bf16(a1, qr[d0], p1, 0, 0, 0);
            }
            const int kv0 = 64 * t;
            if (FOX) {
                const LAS float* cb = (const LAS float*)(L + CBUF + b * 2048 + wid * 256);
#pragma unroll
                for (int g = 0; g < 4; ++g) { const f32x4 c0 = *(const LAS f32x4*)(cb + 8 * g + 4 * hi), c1 = *(const LAS f32x4*)(cb + 32 + 8 * g + 4 * hi);
#pragma unroll
                    for (int i = 0; i < 4; ++i) { p0[4 * g + i] -= c0[i]; p1[4 * g + i] -= c1[i]; } }
                if (kv0 + 63 > qw0) {
#pragma unroll
                    for (int r = 0; r < 16; ++r) { const int kv = kv0 + crow(r, hi); if (kv > qrow) p0[r] = -INFINITY; if (kv + 32 > qrow) p1[r] = -INFINITY; }
                }
            } else {
                const LAS float* bt = (const LAS float*)(L + BTAB);
#pragma unroll
                for (int r = 0; r < 16; ++r) { const int d0_ = qrow - (kv0 + crow(r, hi)), d1_ = d0_ - 32;
                    const bool ok0 = (unsigned)d0_ < 128u, ok1 = (unsigned)d1_ < 128u;
                    const float b0 = bt[ok0 ? d0_ : 0], b1 = bt[ok1 ? d1_ : 0];
                    p0[r] = ok0 ? p0[r] + b0 : -INFINITY; p1[r] = ok1 ? p1[r] + b1 : -INFINITY; }
            }
            float ra = fmaxf(fmaxf(p0[0], p0[1]), p1[0]), rb = fmaxf(fmaxf(p0[2], p0[3]), p1[1]); ra = fmaxf(fmaxf(ra, p1[2]), p1[3]);
#pragma unroll
            for (int r = 4; r < 16; r += 4) { ra = fmaxf(fmaxf(ra, p0[r]), p0[r + 1]); rb = fmaxf(fmaxf(rb, p0[r + 2]), p0[r + 3]); ra = fmaxf(fmaxf(ra, p1[r]), p1[r + 1]); rb = fmaxf(fmaxf(rb, p1[r + 2]), p1[r + 3]); }
            float rm = fmaxf(ra, rb);
            rm = fmaxf(rm, __shfl_xor(rm, 32));
            if (first || __any(rm > 0.f)) {
                const float dl = first ? rm : fmaxf(rm, 0.f), f = first ? 0.f : __builtin_amdgcn_exp2f(-dl);
                m += dl; cinit -= dl; l *= f;
#pragma unroll
                for (int r = 0; r < 16; ++r) { p0[r] -= dl; p1[r] -= dl; o[0][r] *= f; o[1][r] *= f; }
                first = false;
            }
            float ls = 0.f;
#pragma unroll
            for (int r = 0; r < 16; ++r) { p0[r] = __builtin_amdgcn_exp2f(p0[r]); p1[r] = __builtin_amdgcn_exp2f(p1[r]); ls += p0[r] + p1[r]; }
            l += ls;
            bf16x8 pw[4];
#pragma unroll
            for (int s = 0; s < 4; ++s) { u32x4 w;
#pragma unroll
                for (int j = 0; j < 4; ++j) { const float lo = (s < 2) ? p0[8 * (s & 1) + 2 * j] : p1[8 * (s & 1) + 2 * j], hi_ = (s < 2) ? p0[8 * (s & 1) + 2 * j + 1] : p1[8 * (s & 1) + 2 * j + 1]; w[j] = pk2(lo, hi_); }
                pw[s] = __builtin_bit_cast(bf16x8, w); }
            const LAS char* vp = Vb + ((lane >> 4) & 1) * 32 + (lane & 3) * 8 + (4 * hi + ((lane & 15) >> 2)) * 64;
#pragma unroll
            for (int dh = 0; dh < 2; ++dh)
#pragma unroll
                for (int s = 0; s < 4; ++s) { const s16x4 vlo = vtr(vp + dh * 4096 + s * 1024), vhi = vtr(vp + dh * 4096 + s * 1024 + 512);
                    const bf16x8 vf = (bf16x8){vlo[0], vlo[1], vlo[2], vlo[3], vhi[0], vhi[1], vhi[2], vhi[3]};
                    o[dh] = __builtin_amdgcn_mfma_f32_32x32x16_bf16(vf, pw[s], o[dh], 0, 0, 0); }
        }
    }
    asm volatile("s_waitcnt vmcnt(0) lgkmcnt(0)\n\ts_barrier" ::: "memory");
#undef AT_TILE
#undef AT_ISSUE
    l += __shfl_xor(l, 32);
    const float il = 1.0f / l;
    bf16_t* yrow = Y + (FOX ? (size_t)S * 512 : 0) + (size_t)qrow * 512 + h * 64;
#pragma unroll
    for (int dh = 0; dh < 2; ++dh)
#pragma unroll
        for (int g = 0; g < 4; ++g) { u32x2 w; w.x = pk2(o[dh][4 * g] * il, o[dh][4 * g + 1] * il); w.y = pk2(o[dh][4 * g + 2] * il, o[dh][4 * g + 3] * il);
            *(u32x2*)(yrow + dh * 32 + 8 * g + 4 * hi) = w; }
}

__device__ __forceinline__ void attn_phase(Frame& F, const bf16_t* Z, const float* cum, const float* tab, const float* sinks, const float* QN, const float* DG, const float* KN, bf16_t* Y, int qsel = 0) {
    if (F.G == 256) {
        const int b = (int)blockIdx.x, h = b & 7, qb = b >> 3;
        attn_unit<true>(F, h, qb, Z, cum, tab, 0.f, QN, DG, KN, Y);
        attn_unit<true>(F, h ^ 4, 63 - qb, Z, cum, tab, 0.f, QN, DG, KN, Y);
        attn_unit<false>(F, h, qb, Z, cum, tab, sinks[h] * LOG2E, QN, DG, KN, Y);
        attn_unit<false>(F, h ^ 4, 63 - qb, Z, cum, tab, sinks[h ^ 4] * LOG2E, QN, DG, KN, Y);
        return;
    }
    volatile LAS unsigned* qw = (volatile LAS unsigned*)(F.lds + QWORD);
    for (;;) {
        if (F.tid == 0) *qw = __hip_atomic_fetch_add((unsigned*)(F.ctl + CW_QUEUE + 64 * qsel), 1u, __ATOMIC_RELAXED, __HIP_MEMORY_SCOPE_AGENT);
        __syncthreads();
        const unsigned u = *qw;
        __syncthreads();
        if (u >= 1024u) break;
        if (u < 512u) attn_unit<true>(F, (int)(u & 7u), 63 - (int)(u >> 3), Z, cum, tab, 0.f, QN, DG, KN, Y);
        else { const unsigned v = u - 512u; const int h = (int)(v & 7u); attn_unit<false>(F, h, (int)(v >> 3), Z, cum, tab, sinks[h] * LOG2E, QN, DG, KN, Y); }
    }
}
#undef AT_WAIT_BAR
}

template <int MODE> struct EpiMerge {
    static constexpr bool PERM = true;
    const bf16_t* __restrict__ Z; bf16_t* T; bf16_t* O; int gcol; int pad;
    __device__ __forceinline__ void operator()(const f32x4 (&acc)[2][2][4][2], const Unit& u, int wr, int wc, int fr, int fq) const {
        const int row0 = u.pm * 256 + wr * 64 + fr, col0 = u.pn * 256 + wc * 32 + 8 * fq;
#pragma unroll
        for (int aim = 0; aim < (MODE == 1 ? 4 : 2); ++aim) {
            constexpr int MN = (MODE == 1) ? 2 : 4;
            const int ai = (MODE == 1) ? (aim >> 1) : aim, m0 = (MODE == 1) ? (aim & 1) * 2 : 0;
            u32x4 g[4][2], t[4][2];
#pragma unroll
            for (int m = m0; m < m0 + MN; ++m)
#pragma unroll
                for (int bj = 0; bj < 2; ++bj) { const size_t row = (size_t)(row0 + ai * 128 + m * 16); const int col = col0 + bj * 128;
                    g[m][bj] = *(const u32x4*)(Z + row * ZP + gcol + col);
                    if (MODE == 1) t[m][bj] = *(const u32x4*)(T + row * 1024 + col); }
            asm volatile("" ::: "memory");
#pragma unroll
            for (int m = m0; m < m0 + MN; ++m)
#pragma unroll
                for (int bj = 0; bj < 2; ++bj) { const size_t row = (size_t)(row0 + ai * 128 + m * 16); const int col = col0 + bj * 128;
                    const u32x4 gg = g[m][bj];
                    const f32x4 v0 = acc[ai][bj][m][0], v1 = acc[ai][bj][m][1];
                    float r[8];
                    r[0] = sigm(bf_lo(gg.x)) * v0[0]; r[1] = sigm(bf_hi(gg.x)) * v0[1]; r[2] = sigm(bf_lo(gg.y)) * v0[2]; r[3] = sigm(bf_hi(gg.y)) * v0[3];
                    r[4] = sigm(bf_lo(gg.z)) * v1[0]; r[5] = sigm(bf_hi(gg.z)) * v1[1]; r[6] = sigm(bf_lo(gg.w)) * v1[2]; r[7] = sigm(bf_hi(gg.w)) * v1[3];
                    if (MODE == 1) { const u32x4 tt = t[m][bj];
                        r[0] += bf_lo(tt.x); r[1] += bf_hi(tt.x); r[2] += bf_lo(tt.y); r[3] += bf_hi(tt.y); r[4] += bf_lo(tt.z); r[5] += bf_hi(tt.z); r[6] += bf_lo(tt.w); r[7] += bf_hi(tt.w); }
                    u32x4 w; w.x = cvt_pk_bf16(r[0], r[1]); w.y = cvt_pk_bf16(r[2], r[3]); w.z = cvt_pk_bf16(r[4], r[5]); w.w = cvt_pk_bf16(r[6], r[7]);
                    *(u32x4*)((MODE == 0 ? T : O) + row * 1024 + col) = w; }
        }
    }
};
struct EpiResid {
    static constexpr bool PERM = false;
    const float* __restrict__ X; const float* __restrict__ gate; float* O;
    __device__ __forceinline__ void operator()(const f32x4 (&acc)[2][2][4][2], const Unit& u, int wr, int wc, int fr, int fq) const {
        const int row0 = u.pm * 256 + wr * 64 + fr, col0 = u.pn * 256 + wc * 32 + 4 * fq;
#pragma unroll
        for (int bj = 0; bj < 2; ++bj)
#pragma unroll
            for (int n = 0; n < 2; ++n) { const int col = col0 + bj * 128 + n * 16;
                f32x4 xv[2][4]; const f32x4 gv = *(const f32x4*)(gate + col);
#pragma unroll
                for (int ai = 0; ai < 2; ++ai)
#pragma unroll
                    for (int m = 0; m < 4; ++m) xv[ai][m] = *(const f32x4*)(X + (size_t)(row0 + ai * 128 + m * 16) * D + col);
                asm volatile("" ::: "memory");
#pragma unroll
                for (int ai = 0; ai < 2; ++ai)
#pragma unroll
                    for (int m = 0; m < 4; ++m) *(f32x4*)(O + (size_t)(row0 + ai * 128 + m * 16) * D + col) = xv[ai][m] + gv * acc[ai][bj][m][n]; }
    }
};

__device__ __forceinline__ float reduce_scatter32(const float (&a)[32], int lane) {
    float a16[16], a8[8], a4[4], a2[2];
    const bool b5 = lane & 32, b4 = lane & 16, b3 = lane & 8, b2 = lane & 4, b1 = lane & 2;
#pragma unroll
    for (int i = 0; i < 16; ++i) { const float keep = b5 ? a[i + 16] : a[i], send = b5 ? a[i] : a[i + 16]; a16[i] = keep + __shfl_xor(send, 32); }
#pragma unroll
    for (int i = 0; i < 8; ++i) { const float keep = b4 ? a16[i + 8] : a16[i], send = b4 ? a16[i] : a16[i + 8]; a8[i] = keep + __shfl_xor(send, 16); }
#pragma unroll
    for (int i = 0; i < 4; ++i) { const float keep = b3 ? a8[i + 4] : a8[i], send = b3 ? a8[i] : a8[i + 4]; a4[i] = keep + __shfl_xor(send, 8); }
#pragma unroll
    for (int i = 0; i < 2; ++i) { const float keep = b2 ? a4[i + 2] : a4[i], send = b2 ? a4[i] : a4[i + 2]; a2[i] = keep + __shfl_xor(send, 4); }
    const float keep = b1 ? a2[1] : a2[0], send = b1 ? a2[0] : a2[1];
    float v = keep + __shfl_xor(send, 2);
    v += __shfl_xor(v, 1);
    return v;
}
__device__ __forceinline__ void p6_route(Frame& F, const float* X1, const float* g, const float* mod, const float* w_router, const float* b_router, unsigned char* U2, int* sel_ep, float* sel_w, int* list) {
    LAS float* wr = (LAS float*)F.lds;
    LAS int* selE = (LAS int*)(F.lds + ROWTAB_OFF);
    LAS int* lcnt = (LAS int*)(F.lds + LDSCTL_OFF);
    LAS int* gbase = lcnt + 32;
    for (int i = F.tid; i < 32768; i += NWAVES * 64) wr[(i & 31) * 1024 + (i >> 5)] = w_router[i];
    if (F.tid < 64) lcnt[F.tid] = 0;
    f32x4 gv[4], sc1[4], sh[4];
#pragma unroll
    for (int j = 0; j < 4; ++j) { const int o = 4 * F.lane + 256 * j; gv[j] = *(const f32x4*)(g + o); sc1[j] = *(const f32x4*)(mod + 4096 + o) + 1.0f; sh[j] = *(const f32x4*)(mod + 3072 + o); }
    const float brv = b_router[F.lane >> 1];
    __syncthreads();
    const int gw = F.vcu * NWAVES + F.wave, NGW = F.G * NWAVES;
    int it = 0;
    for (int rp6 = 0; rp6 < ((REPMASK & 0x40000) ? 2 : 1); ++rp6) { it = 0;
    for (int m = gw; m < S; m += NGW, ++it) {
        const GAS f32x4* xr = (const GAS f32x4*)(X1 + (size_t)m * D) + F.lane;
        f32x4 v[4]; float ss = 0.f;
#pragma unroll
        for (int j = 0; j < 4; ++j) { v[j] = xr[64 * j]; ss += (v[j].x * v[j].x + v[j].y * v[j].y) + (v[j].z * v[j].z + v[j].w * v[j].w); }
        const float r = 1.0f / sqrtf(wave_sum(ss) * (1.f / D) + EPS);
        GAS unsigned* o4 = (GAS unsigned*)(U2 + (size_t)m * D) + F.lane;
#pragma unroll
        for (int j = 0; j < 4; ++j) { v[j] = v[j] * r * gv[j] * sc1[j] + sh[j];
            o4[64 * j] = pk_fp8x4(v[j].x, v[j].y, v[j].z, v[j].w); }
        float acc[32];
#pragma unroll
        for (int e = 0; e < 32; ++e) { float a = 0.f;
#pragma unroll
            for (int j = 0; j < 4; ++j) { const f32x4 w4 = *(const LAS f32x4*)(wr + e * 1024 + 4 * F.lane + 256 * j); a += (v[j].x * w4.x + v[j].y * w4.y) + (v[j].z * w4.z + v[j].w * w4.w); }
            acc[e] = a; }
        float lv = reduce_scatter32(acc, F.lane) + brv;
        float tv[4]; int te[4];
#pragma unroll
        for (int k = 0; k < 4; ++k) { const float mx = wave_max(lv); const unsigned long long bal = __ballot(lv == mx); const int e = (__ffsll((long long)bal) - 1) >> 1;
            tv[k] = mx; te[k] = e; if ((F.lane >> 1) == e) lv = -INFINITY; }
        float p[4], sum = 0.f;
#pragma unroll
        for (int k = 0; k < 4; ++k) { p[k] = expf(tv[k] - tv[0]); sum += p[k]; }
        if (F.lane < 4) { float pw = p[0]; int ew = te[0];
#pragma unroll
            for (int k = 1; k < 4; ++k) { pw = (F.lane == k) ? p[k] : pw; ew = (F.lane == k) ? te[k] : ew; }
            sel_w[(size_t)m * 4 + F.lane] = pw / sum; selE[(it * NWAVES + F.wave) * 4 + F.lane] = ew; }
    } }
    __syncthreads();
    const int nrows = it * NWAVES;
    int myE[2], myL[2];
#pragma unroll
    for (int q = 0; q < 2; ++q) { const int t = F.tid + q * NWAVES * 64; myE[q] = 0; myL[q] = 0; if (t < nrows * 4) { myE[q] = selE[t]; myL[q] = __hip_atomic_fetch_add(&lcnt[myE[q]], 1, __ATOMIC_RELAXED, __HIP_MEMORY_SCOPE_WORKGROUP); } }
    __syncthreads();
    if (F.tid < 32) gbase[F.tid] = (int)__hip_atomic_fetch_add((unsigned*)(F.ctl + CW_CNT + F.tid), (unsigned)lcnt[F.tid], __ATOMIC_RELAXED, __HIP_MEMORY_SCOPE_AGENT);
    __syncthreads();
#pragma unroll
    for (int q = 0; q < 2; ++q) { const int t = F.tid + q * NWAVES * 64; if (t < nrows * 4) { const int rl = t >> 2, e = myE[q], pos = gbase[e] + myL[q];
        const int tok = (F.vcu * NWAVES + (rl & 7)) + (rl >> 3) * NGW; list[(size_t)e * S + pos] = tok; sel_ep[(size_t)tok * 4 + (t & 3)] = (e << 16) | pos; } }
    __syncthreads();
}

__device__ __forceinline__ void moe_tables(Frame& F) {
    LAS int* tp = (LAS int*)(F.lds + LDSCTL_OFF);
    LAS int* cn = tp + 40;
    if (F.tid == 0) { int t = 0; for (int e = 0; e < NE; ++e) { const int c = (int)__hip_atomic_load((unsigned*)(F.ctl + CW_CNT + e), __ATOMIC_RELAXED, __HIP_MEMORY_SCOPE_AGENT); tp[e] = t; cn[e] = c; t += (c + 255) >> 8; } tp[NE] = t; }
    __syncthreads();
}
template <bool GATHER> struct MoeOrder {
    const LAS int* tp; const LAS int* rowtab; const char* A; const char* Bt; size_t bstride; int NT, RB, U, per, nb, x, rank;
    __device__ void init(Frame& F, const void* A_, const void* Bt_, size_t bstride_, int NT_, int RB_) {
        tp = (const LAS int*)(F.lds + LDSCTL_OFF); rowtab = (const LAS int*)(F.lds + ROWTAB_OFF); A = (const char*)A_; Bt = (const char*)Bt_; bstride = bstride_; NT = NT_; RB = RB_;
        U = tp[NE] * NT;
        if (F.G % 8 == 0) { nb = F.G >> 3; x = blockIdx.x & 7; rank = blockIdx.x >> 3; per = (U + 7) >> 3; } else { nb = F.G; x = 0; rank = blockIdx.x; per = U; }
    }
    __device__ bool next(int i, Unit& u) const {
        const int p = i * nb + rank; if (p >= per) return false;
        const int id = x * per + p; if (id >= U) return false;
        const int mtg = id / NT, nt = id - mtg * NT;
        int e = 0; while (tp[e + 1] <= mtg) ++e;
        e = __builtin_amdgcn_readfirstlane(e);
        u.pm = mtg; u.pn = nt; u.e = e; u.slot = i;
        u.A = pg8::uniform_ptr(GATHER ? A : A + (size_t)mtg * 256 * RB); u.B = pg8::uniform_ptr(Bt + (size_t)e * bstride + (size_t)nt * 256 * RB); return true;
    }
    __device__ __forceinline__ int arow(int slot, int r) const { return rowtab[slot * 256 + r]; }
};
__device__ __forceinline__ void moe_rowtab(Frame& F, const MoeOrder<true>& So, const int* list) {
    const LAS int* tp = (const LAS int*)(F.lds + LDSCTL_OFF); const LAS int* cn = tp + 40;
    LAS int* rowtab = (LAS int*)(F.lds + ROWTAB_OFF);
    Unit u;
    for (int i = 0; i < ROWTAB_UNITS && So.next(i, u); ++i) {
        if (F.tid < 256) { const int pos = (u.pm - tp[u.e]) * 256 + F.tid; rowtab[i * 256 + F.tid] = list[(size_t)u.e * S + (pos < cn[u.e] ? pos : 0)]; }
    }
    __syncthreads();
}
struct EpiMoe1 {
    static constexpr bool PERM = true; static constexpr int SCALE_W = 0x79797979  , SCALE_A = 0x7f7f7f7f;
    const float* bgl; unsigned char* ACT;
    __device__ __forceinline__ void operator()(const f32x4 (&acc)[2][2][4][2], const Unit& u, int wr, int wc, int fr, int fq) const {
        const int row0 = u.pm * 256 + wr * 64 + fr, acol = u.pn * 128 + wc * 32 + 8 * fq;
        const float* bg = bgl + (size_t)u.e * 2048 + acol;
        const f32x4 bg0 = *(const f32x4*)bg, bg1 = *(const f32x4*)(bg + 4), bl0 = *(const f32x4*)(bg + 1024), bl1 = *(const f32x4*)(bg + 1028);
#pragma unroll
        for (int ai = 0; ai < 2; ++ai)
#pragma unroll
            for (int m = 0; m < 4; ++m) { const size_t row = (size_t)(row0 + ai * 128 + m * 16);
                const f32x4 g0 = acc[ai][0][m][0] + bg0, g1 = acc[ai][0][m][1] + bg1, l0 = acc[ai][1][m][0] + bl0, l1 = acc[ai][1][m][1] + bl1;
                float r[8];
#pragma unroll
                for (int i = 0; i < 4; ++i) { const float ga = fminf(g0[i], 7.0f), la = fminf(fmaxf(l0[i], -7.0f), 7.0f), gb = fminf(g1[i], 7.0f), lb = fminf(fmaxf(l1[i], -7.0f), 7.0f);
                    r[i] = ga * sigm(1.702f * ga) * (la + 1.0f) * ACT_SCALE; r[4 + i] = gb * sigm(1.702f * gb) * (lb + 1.0f) * ACT_SCALE; }
                u32x2 w; w.x = pk_fp8x4(r[0], r[1], r[2], r[3]); w.y = pk_fp8x4(r[4], r[5], r[6], r[7]);
                *(u32x2*)(ACT + row * FF + acol) = w; }
    }
};
struct EpiMoe2 {
    static constexpr bool PERM = true; static constexpr int SCALE_W = 0x79797979  , SCALE_A = 0x7c7c7c7c  ;
    const float* b2; bf16_t* Y;
    __device__ __forceinline__ void operator()(const f32x4 (&acc)[2][2][4][2], const Unit& u, int wr, int wc, int fr, int fq) const {
        const int row0 = u.pm * 256 + wr * 64 + fr, col0 = u.pn * 256 + wc * 32 + 8 * fq;
        f32x4 bv[2][2];
#pragma unroll
        for (int bj = 0; bj < 2; ++bj)
#pragma unroll
            for (int n = 0; n < 2; ++n) bv[bj][n] = *(const f32x4*)(b2 + (size_t)u.e * D + col0 + bj * 128 + 4 * n);
#pragma unroll
        for (int ai = 0; ai < 2; ++ai)
#pragma unroll
            for (int m = 0; m < 4; ++m) { bf16_t* rowp = Y + (size_t)(row0 + ai * 128 + m * 16) * D + col0;
#pragma unroll
                for (int bj = 0; bj < 2; ++bj) { const f32x4 v0 = acc[ai][bj][m][0] + bv[bj][0], v1 = acc[ai][bj][m][1] + bv[bj][1];
                    u32x4 w; w.x = cvt_pk_bf16(v0[0], v0[1]); w.y = cvt_pk_bf16(v0[2], v0[3]); w.z = cvt_pk_bf16(v1[0], v1[1]); w.w = cvt_pk_bf16(v1[2], v1[3]);
                    *(u32x4*)(rowp + bj * 128) = w; } }
    }
};

__device__ __forceinline__ void p9_final(Frame& F, const float* X1, const bf16_t* Y, const float* gate, const float* g, const int* sel_ep, const float* sel_w, float* out) {
    const LAS int* tp = (const LAS int*)(F.lds + LDSCTL_OFF);
    f32x4 gv[4], gt[4];
#pragma unroll
    for (int j = 0; j < 4; ++j) { const int o = 4 * F.lane + 256 * j; gv[j] = *(const f32x4*)(g + o); gt[j] = *(const f32x4*)(gate + o); }
    const int gw = F.vcu * NWAVES + F.wave, NGW = F.G * NWAVES;
    for (int m = gw; m < S; m += NGW) {
        f32x4 mo[4];
#pragma unroll
        for (int j = 0; j < 4; ++j) mo[j] = (f32x4){0.f, 0.f, 0.f, 0.f};
#pragma unroll
        for (int k = 0; k < 4; ++k) { const int ep = sel_ep[(size_t)m * 4 + k]; const float w = sel_w[(size_t)m * 4 + k]; const int slot = tp[ep >> 16] * 256 + (ep & 0xffff);
            const GAS u32x2* yr = (const GAS u32x2*)(Y + (size_t)slot * D) + F.lane;
#pragma unroll
            for (int j = 0; j < 4; ++j) { const u32x2 t = yr[64 * j]; mo[j] += w * (f32x4){bf_lo(t.x), bf_hi(t.x), bf_lo(t.y), bf_hi(t.y)}; } }
        const GAS f32x4* xr = (const GAS f32x4*)(X1 + (size_t)m * D) + F.lane;
        f32x4 v[4]; float ss = 0.f;
#pragma unroll
        for (int j = 0; j < 4; ++j) { v[j] = xr[64 * j] + gt[j] * mo[j]; ss += (v[j].x * v[j].x + v[j].y * v[j].y) + (v[j].z * v[j].z + v[j].w * v[j].w); }
        const float r = 1.0f / sqrtf(wave_sum(ss) * (1.f / D) + EPS);
        GAS f32x4* orow = (GAS f32x4*)(out + (size_t)m * D) + F.lane;
#ifdef TSTAMP
        { const unsigned long long* tsp = (const unsigned long long*)((const char*)sel_ep - WS_SEL + WS_CTL + 512 * 1024); const float us = (float)(tsp[0] - tsp[1]) * 0.01f; const float fac = 1.0f + 0.05f * floorf((us + TSTAMP_OFF) * (1.0f / TSTAMP_BIN));
#pragma unroll
          for (int j = 0; j < 4; ++j) orow[64 * j] = v[j] * r * gv[j] * fac; }
#else
#pragma unroll
        for (int j = 0; j < 4; ++j) orow[64 * j] = v[j] * r * gv[j];
#endif
    }
}

struct Args { const float* in[20]; float* out; unsigned char* ws; int ph_lo, ph_hi; };
enum { PH_SMALL = 0, PH_ROWS, PH_INPROJ, PH_CUM, PH_ATTN, PH_MERGE, PH_WO, PH_ROUTE, PH_MOE1, PH_MOE2, PH_FINAL, PH_COUNT };

__global__ void __launch_bounds__(NWAVES * 64, 2) mk_fwd(Args args) {
    extern __shared__ __attribute__((aligned(16))) unsigned char lds[];
    Frame F;
    F.lds = (LAS unsigned char*)lds;
    F.MISC = (volatile LAS unsigned*)(F.lds + MISC_OFF);
    F.tid = threadIdx.x; F.lane = F.tid & 63; F.wave = __builtin_amdgcn_readfirstlane(F.tid >> 6);
    F.G = gridDim.x; { const int bx = blockIdx.x; F.vcu = (F.G % 8 == 0) ? (bx % 8) * (F.G / 8) + bx / 8 : bx; }
    unsigned char* ws = args.ws;
    F.ctl = (gu32*)(ws + WS_CTL);
    for (int u = F.tid; u < (LDS_BYTES - LDSCTL_OFF) / 4; u += NWAVES * 64) ((LAS unsigned*)(F.lds + LDSCTL_OFF))[u] = 0u;
    __syncthreads();
    XcdBarrier bar = xcd_barrier_post((unsigned*)(F.ctl + CW_BAR), F.MISC + 8);
    const int lo = args.ph_lo, hi = args.ph_hi;
#ifdef TSTAMP
    const unsigned long long ts0 = __builtin_amdgcn_s_memrealtime();
#endif
#ifndef REPMASK
#define REPMASK 0
#endif
#define IN(k) (lo <= (k) && (k) < hi)
#define REPS(k) (((REPMASK >> (k)) & 1) ? 2 : 1)
#define REPEAT(k, ...) { __VA_ARGS__ if (REPS(k) == 2) { __VA_ARGS__ } }
#ifdef TSTAMP
#define SEAM(k) do { if (IN((k) + 1)) xcd_barrier(bar); if ((k) == TSTAMP_LO && blockIdx.x == 0 && F.tid == 0) ((unsigned long long*)(ws + WS_CTL + 512 * 1024))[1] = __builtin_amdgcn_s_memrealtime() - ts0; if ((k) == TSTAMP && blockIdx.x == 0 && F.tid == 0) ((unsigned long long*)(ws + WS_CTL + 512 * 1024))[0] = __builtin_amdgcn_s_memrealtime() - ts0; } while (0)
#else
#define SEAM(k) do { if (IN((k) + 1)) xcd_barrier(bar); } while (0)
#endif
    const float* x = args.in[0]; const float* c = args.in[1]; const float* w_ada = args.in[2]; const float* b_ada = args.in[3]; const float* g_mix = args.in[4]; const float* w_in = args.in[5];
    const float* b_forget = args.in[6]; const float* sinks = args.in[7]; const float* rel = args.in[8]; const float* w_pa = args.in[9]; const float* w_pb = args.in[10]; const float* w_o = args.in[11];
    const float* g_ffn = args.in[12]; const float* w_router = args.in[13]; const float* b_router = args.in[14]; const float* w_e1 = args.in[15]; const float* b_e1 = args.in[16];
    const float* w_e2 = args.in[17]; const float* b_e2 = args.in[18]; const float* g_final = args.in[19];
    float* mod = (float*)(ws + WS_MOD); float* tab = (float*)(ws + WS_TAB); float* bgl = (float*)(ws + WS_BGL); float* logfb = (float*)(ws + WS_LOGF); float* cum = (float*)(ws + WS_CUM);
    bf16_t* Win = (bf16_t*)(ws + WS_WIN); bf16_t* Wpa = (bf16_t*)(ws + WS_WPA); bf16_t* Wpb = (bf16_t*)(ws + WS_WPB); bf16_t* Wo = (bf16_t*)(ws + WS_WO);
    unsigned char* We1 = ws + WS_WE1; unsigned char* We2 = ws + WS_WE2;
    bf16_t* U = (bf16_t*)(ws + WS_U); bf16_t* Z = (bf16_t*)(ws + WS_Z);

    if (IN(PH_SMALL)) { p0_small(F, c, w_ada, b_ada, rel, b_e1, mod, tab, bgl); }
    const ConvPtrs CP{w_in, w_pa, w_pb, w_o, w_e1, w_e2, Win, Wpa, Wpb, Wo, We1, We2};
#ifndef CV_SPLIT
#define CV_SPLIT CV_TOTAL
#endif
    if (IN(PH_ROWS)) { conv_range(F, CP, 0, CV_SPLIT); __syncthreads(); wait_mod(F); p1_rows(F, x, g_mix, mod, w_in, b_forget, U, logfb); SEAM(PH_ROWS); }
    if (IN(PH_INPROJ)) {
        pg8::DenseOrder So; So.init(U, Win, S, ZP, D, F.G, (int)blockIdx.x);
        EpiInProj E{Z};
        REPEAT(PH_INPROJ, pg8::gemm_phase<EpiInProj, pg8::DenseOrder, true, false>(F.lds + RING_OFF, D, So, E);)
        if (F.G == 256) p2b_cum(F, logfb, cum, 64);
        SEAM(PH_INPROJ);
    }
    if (IN(PH_CUM)) { if (F.G != 256) p2b_cum(F, logfb, cum, 0); p2b_stats(F, Z, (float*)(ws + WS_TMP), (float*)(ws + WS_TMP) + 8 * S, (float*)(ws + WS_TMP) + 16 * S); SEAM(PH_CUM); }
    bf16_t* YAB = (bf16_t*)(ws + WS_YAB); bf16_t* TMP = (bf16_t*)(ws + WS_TMP); bf16_t* MRG = (bf16_t*)(ws + WS_MRG); float* X1 = (float*)(ws + WS_X1);
    if (IN(PH_ATTN)) { at::attn_phase(F, Z, cum, tab, sinks, (const float*)(ws + WS_TMP), (const float*)(ws + WS_TMP) + 8 * S, (const float*)(ws + WS_TMP) + 16 * S, YAB); if (REPS(PH_ATTN) == 2) at::attn_phase(F, Z, cum, tab, sinks, (const float*)(ws + WS_TMP), (const float*)(ws + WS_TMP) + 8 * S, (const float*)(ws + WS_TMP) + 16 * S, YAB, 1); SEAM(PH_ATTN); }
    if (IN(PH_MERGE)) { REPEAT(PH_MERGE,
        { pg8::DenseOrder So; So.init(YAB, Wpa, S, D, 512, F.G, (int)blockIdx.x); EpiMerge<0> E{Z, TMP, MRG, C_GA, 0};
          pg8::gemm_phase<EpiMerge<0>, pg8::DenseOrder, true, false>(F.lds + RING_OFF, 512, So, E); }
        { pg8::DenseOrder So; So.init(YAB + (size_t)S * 512, Wpb, S, D, 512, F.G, (int)blockIdx.x); EpiMerge<1> E{Z, TMP, MRG, C_GB, 0};
          pg8::gemm_phase<EpiMerge<1>, pg8::DenseOrder, true, false>(F.lds + RING_OFF, 512, So, E); } )
        SEAM(PH_MERGE);
    }
    if (IN(PH_WO)) {
        pg8::DenseOrder So; So.init(MRG, Wo, S, D, D, F.G, (int)blockIdx.x); EpiResid E{x, mod + 2048, X1};
        REPEAT(PH_WO, pg8::gemm_phase<EpiResid, pg8::DenseOrder, true, false>(F.lds + RING_OFF, D, So, E);)
        SEAM(PH_WO);
    }
    int* sel_ep = (int*)(ws + WS_SEL); float* sel_w = (float*)(ws + WS_SEL + 262144); int* list = (int*)(ws + WS_LIST);
    unsigned char* ACT = ws + WS_ACT; bf16_t* Y = (bf16_t*)(ws + WS_Y); unsigned char* U8 = ws + WS_U;
    if (IN(PH_ROUTE)) { p6_route(F, X1, g_ffn, mod, w_router, b_router, U8, sel_ep, sel_w, list); conv_range(F, CP, CV_SPLIT, CV_TOTAL); SEAM(PH_ROUTE); }
    if (IN(PH_MOE1)) {
        moe_tables(F); MoeOrder<true> So; So.init(F, U8, We1, (size_t)2048 * D, 8, D); moe_rowtab(F, So, list);
        EpiMoe1 E{bgl, ACT};
        REPEAT(PH_MOE1, pg8::gemm_phase<EpiMoe1, MoeOrder<true>, true, true, true>(F.lds + RING_OFF, D, So, E);)
        SEAM(PH_MOE1);
    }
    if (IN(PH_MOE2)) {
        moe_tables(F); MoeOrder<false> So; So.init(F, ACT, We2, (size_t)D * FF, 4, FF);
        EpiMoe2 E{b_e2, Y};
        REPEAT(PH_MOE2, pg8::gemm_phase<EpiMoe2, MoeOrder<false>, true, false, true>(F.lds + RING_OFF, FF, So, E);)
        SEAM(PH_MOE2);
    }
    if (IN(PH_FINAL)) { moe_tables(F); REPEAT(PH_FINAL, p9_final(F, X1, Y, mod + 5120, g_final, sel_ep, sel_w, args.out);) }

#undef IN
#undef SEAM
}
}


extern "C" void kernel_launch(void* const* d_in, const int* in_sizes, int n_in, void* d_out, int out_size, void* d_ws, size_t ws_size, hipStream_t stream) {
    static int grid = 0;
    if (grid == 0) {
        int dev = 0, cus = 0;
        if (n_in != 20 || out_size != mk::S * mk::D || ws_size < mk::WS_END) { fprintf(stderr, "kernel_launch: unexpected shapes / workspace (%d inputs, out %d, ws %zu)\n", n_in, out_size, ws_size); grid = -1; return; }
        if (hipGetDevice(&dev) != hipSuccess || hipDeviceGetAttribute(&cus, hipDeviceAttributeMultiprocessorCount, dev) != hipSuccess) { grid = -1; return; }
        if (hipFuncSetAttribute((const void*)mk::mk_fwd, hipFuncAttributeMaxDynamicSharedMemorySize, mk::LDS_BYTES) != hipSuccess) { fprintf(stderr, "hipFuncSetAttribute failed\n"); grid = -1; return; }
        int per_cu = 0;
        if (hipOccupancyMaxActiveBlocksPerMultiprocessor(&per_cu, (const void*)mk::mk_fwd, mk::NWAVES * 64, mk::LDS_BYTES) != hipSuccess || per_cu < 1) { fprintf(stderr, "occupancy query: %d\n", per_cu); (void)hipGetLastError(); grid = -1; return; }
        grid = cus;
        if (mk::S % (grid * mk::NWAVES) != 0 || grid % 8 != 0) { fprintf(stderr, "kernel_launch: built for a CU count that divides %d rows evenly (got %d)\n", mk::S, cus); grid = -1; return; }
    }
    if (grid < 0) return;
    (void)hipMemsetAsync((char*)d_ws + mk::WS_CTL, 0, mk::CTL_ZERO_BYTES, stream);
    mk::Args a{};
    for (int i = 0; i < 20; ++i) a.in[i] = (const float*)d_in[i];
    a.out = (float*)d_out; a.ws = (unsigned char*)d_ws; a.ph_lo = 0; a.ph_hi = mk::PH_COUNT;
    hipLaunchKernelGGL(mk::mk_fwd, dim3(grid), dim3(mk::NWAVES * 64), mk::LDS_BYTES, stream, a);
}
```
